# Optimizing an MI355X kernel written in HIP

```python
import jax, jax.numpy as jnp
from jax import lax
import numpy as np

D_MODEL = 1024
BATCH = 32
SEQ = 2048
DEPTH = 1
DEC_BATCH = 16
DEC_SEQ = 32
PAST_LEN = 1024

CHUNK = 64
CONV_W = 4
D_LRU = D_MODEL
LRU_HEADS = 8
LRU_BLOCK = D_LRU // LRU_HEADS
LRU_C = 8.0
D_SSD = D_MODEL
SSD_HEADS = 16
SSD_HEAD_DIM = D_SSD // SSD_HEADS
SSD_GROUPS = 2
SSD_HPG = SSD_HEADS // SSD_GROUPS
SSD_STATE = 128
D_XBC = D_SSD + 2 * SSD_GROUPS * SSD_STATE
D_MIX = D_LRU + D_SSD
IN_COLS = 2 * D_LRU + D_XBC + D_SSD + SSD_HEADS
EPS = 1e-6

kernel_name = "hawk_ssd_parallel_streaming_encoder_step"


def rmsnorm(x, g):
    xf = x.astype(jnp.float32)
    y = xf * lax.rsqrt(jnp.mean(xf * xf, axis=-1, keepdims=True) + EPS)
    return (y * g.astype(jnp.float32)).astype(x.dtype)


def causal_conv(u, buf, w, b):
    L = u.shape[1]
    ext = jnp.concatenate([buf.astype(u.dtype), u], axis=1)
    out = b + sum(ext[:, k:k + L] * w[k] for k in range(CONV_W))
    return out, ext[:, L:]


def block_diag(u, w, b):
    Bsz, L, _ = u.shape
    uh = u.reshape(Bsz, L, LRU_HEADS, LRU_BLOCK)
    return jnp.einsum('blhi,hij->blhj', uh, w).reshape(Bsz, L, D_LRU) + b


def rg_lru(u, h0, w_a, b_a, w_x, b_x, lam, start):
    L = u.shape[1]
    uf = u.astype(jnp.float32)
    r = jax.nn.sigmoid(block_diag(uf, w_a.astype(jnp.float32), b_a.astype(jnp.float32)))
    i = jax.nn.sigmoid(block_diag(uf, w_x.astype(jnp.float32), b_x.astype(jnp.float32)))
    log_a = -LRU_C * r * jax.nn.softplus(-lam.astype(jnp.float32))
    a = jnp.exp(log_a)
    mult = jnp.sqrt(-jnp.expm1(2.0 * log_a))
    reset = (start + jnp.arange(L)) == 0
    mult = jnp.where(reset[None, :, None], 1.0, mult)
    bv = mult * (i * uf)
    bv = bv.at[:, 0].add(a[:, 0] * h0.astype(jnp.float32))

    def combine(p, q):
        return p[0] * q[0], q[0] * p[1] + q[1]

    _, h = lax.associative_scan(combine, (a, bv), axis=1)
    return h, h[:, -1]


def segsum(x):
    T = x.shape[-1]
    xr = jnp.broadcast_to(x[..., :, None], x.shape + (T,))
    xr = jnp.where(jnp.tril(jnp.ones((T, T), bool), -1), xr, 0.0)
    s = jnp.cumsum(xr, axis=-2)
    return jnp.where(jnp.tril(jnp.ones((T, T), bool)), s, -jnp.inf)


def ssd_scan(x, dA, Bm, Cm, s0, q):
    b_, l = x.shape[:2]
    c = l // q
    x = x.reshape(b_, c, q, SSD_GROUPS, SSD_HPG, SSD_HEAD_DIM)
    Bm = Bm.reshape(b_, c, q, SSD_GROUPS, SSD_STATE)
    Cm = Cm.reshape(b_, c, q, SSD_GROUPS, SSD_STATE)
    A = dA.reshape(b_, c, q, SSD_GROUPS, SSD_HPG).transpose(0, 3, 4, 1, 2)
    A_cs = jnp.cumsum(A, axis=-1)
    Lm = jnp.exp(segsum(A))
    CB = jnp.einsum('bclgn,bcsgn->bcgls', Cm, Bm)
    y_diag = jnp.einsum('bcgls,bgkcls,bcsgkp->bclgkp', CB, Lm, x)
    decay_states = jnp.exp(A_cs[..., -1:] - A_cs)
    states = jnp.einsum('bcsgn,bgkcs,bcsgkp->bcgkpn', Bm, decay_states, x)
    states = jnp.concatenate([s0[:, None], states], axis=1)
    chunk_A = jnp.pad(A_cs[..., -1], ((0, 0), (0, 0), (0, 0), (1, 0)))
    decay_chunk = jnp.exp(segsum(chunk_A))
    new_states = jnp.einsum('bgkzc,bcgkpn->bzgkpn', decay_chunk, states)
    start_states, final = new_states[:, :-1], new_states[:, -1]
    y_off = jnp.einsum('bclgn,bcgkpn,bgkcl->bclgkp', Cm, start_states, jnp.exp(A_cs))
    y = (y_diag + y_off).reshape(b_, l, SSD_GROUPS, SSD_HPG, SSD_HEAD_DIM)
    return y, final


def mixer_layer(x, c, buf_lru, h_lru, buf_ssd, s_ssd, start, q, p):
    Bsz, L, _ = x.shape
    mod = jax.nn.silu(c) @ p['w_ada'] + p['b_ada']
    shift, scale, gate = jnp.split(mod, 3, axis=-1)
    hn = rmsnorm(x, p['norm_g']) * (1.0 + scale[:, None]) + shift[:, None]
    proj = hn @ p['w_in']
    lru_x, lru_g, xbc, z, dt_raw = jnp.split(
        proj, [D_LRU, 2 * D_LRU, 2 * D_LRU + D_XBC, 2 * D_LRU + D_XBC + D_SSD], axis=-1)

    u, new_buf_lru = causal_conv(lru_x, buf_lru, p['lru_conv_w'], p['lru_conv_b'])
    h, new_h = rg_lru(u, h_lru, p['lru_w_a'], p['lru_b_a'], p['lru_w_x'], p['lru_b_x'],
                      p['lru_lambda'], start)
    y_lru = h.astype(x.dtype) * jax.nn.silu(lru_g)

    xbc_c, new_buf_ssd = causal_conv(xbc, buf_ssd, p['ssd_conv_w'], p['ssd_conv_b'])
    xbc_c = jax.nn.silu(xbc_c).astype(jnp.float32)
    xs, Bm, Cm = jnp.split(xbc_c, [D_SSD, D_SSD + SSD_GROUPS * SSD_STATE], axis=-1)
    xs = xs.reshape(Bsz, L, SSD_GROUPS, SSD_HPG, SSD_HEAD_DIM)
    Bm = Bm.reshape(Bsz, L, SSD_GROUPS, SSD_STATE)
    Cm = Cm.reshape(Bsz, L, SSD_GROUPS, SSD_STATE)
    dt = jax.nn.softplus(dt_raw.astype(jnp.float32) + p['ssd_dt_bias'].astype(jnp.float32))
    dt = dt.reshape(Bsz, L, SSD_GROUPS, SSD_HPG)
    A = -jnp.exp(p['ssd_a_log'].astype(jnp.float32)).reshape(SSD_GROUPS, SSD_HPG)
    y, new_s = ssd_scan(xs * dt[..., None], dt * A, Bm, Cm, s_ssd.astype(jnp.float32), q)
    y = y + p['ssd_d'].astype(jnp.float32).reshape(SSD_GROUPS, SSD_HPG)[:, :, None] * xs
    yz = y.reshape(Bsz, L, D_SSD) * jax.nn.silu(z.astype(jnp.float32))
    yz = yz.reshape(Bsz, L, SSD_GROUPS, D_SSD // SSD_GROUPS)
    y_ssd = rmsnorm(yz, p['ssd_norm_g'].reshape(SSD_GROUPS, D_SSD // SSD_GROUPS))
    y_ssd = y_ssd.reshape(Bsz, L, D_SSD).astype(x.dtype)

    mix = jnp.concatenate([y_lru, y_ssd], axis=-1) @ p['w_out']
    out = x + gate[:, None] * mix
    return (out, new_buf_lru, new_h.astype(x.dtype), new_buf_ssd, new_s.astype(x.dtype))


def setup_inputs(seed: int = 0) -> dict:
    key = jax.random.key(seed)
    ks = jax.random.split(key, 32)
    nrm = lambda k, s, sc: jax.random.normal(k, s, jnp.float32) * sc
    a0 = jax.random.uniform(ks[20], (DEPTH, D_LRU), jnp.float32, 0.9, 0.999)
    dt0 = jnp.exp(jax.random.uniform(ks[21], (DEPTH, SSD_HEADS), jnp.float32,
                                     np.log(1e-3), np.log(1e-1)))
    return {
        'x_prompt': nrm(ks[0], (BATCH, SEQ, D_MODEL), 1.0),
        'x_sample': nrm(ks[1], (DEC_BATCH, DEC_SEQ, D_MODEL), 1.0),
        'c_prompt': nrm(ks[2], (BATCH, D_MODEL), 1.0),
        'c_sample': nrm(ks[3], (DEC_BATCH, D_MODEL), 1.0),
        'state_lru_conv': nrm(ks[4], (DEPTH, DEC_BATCH, CONV_W - 1, D_LRU), 1.0),
        'state_lru_h': nrm(ks[5], (DEPTH, DEC_BATCH, D_LRU), 1.0),
        'state_ssd_conv': nrm(ks[6], (DEPTH, DEC_BATCH, CONV_W - 1, D_XBC), 1.0),
        'state_ssd': nrm(ks[7], (DEPTH, DEC_BATCH, SSD_GROUPS, SSD_HPG, SSD_HEAD_DIM, SSD_STATE), 0.1),
        'norm_g': 1.0 + nrm(ks[8], (DEPTH, D_MODEL), 0.02),
        'w_ada': nrm(ks[9], (DEPTH, D_MODEL, 3 * D_MODEL), 0.5 * D_MODEL ** -0.5),
        'b_ada': nrm(ks[10], (DEPTH, 3 * D_MODEL), 0.01),
        'w_in': nrm(ks[11], (DEPTH, D_MODEL, IN_COLS), D_MODEL ** -0.5),
        'lru_conv_w': nrm(ks[12], (DEPTH, CONV_W, D_LRU), CONV_W ** -0.5),
        'lru_conv_b': nrm(ks[13], (DEPTH, D_LRU), 0.01),
        'lru_w_a': nrm(ks[14], (DEPTH, LRU_HEADS, LRU_BLOCK, LRU_BLOCK), LRU_BLOCK ** -0.5),
        'lru_b_a': nrm(ks[15], (DEPTH, D_LRU), 0.01),
        'lru_w_x': nrm(ks[16], (DEPTH, LRU_HEADS, LRU_BLOCK, LRU_BLOCK), LRU_BLOCK ** -0.5),
        'lru_b_x': nrm(ks[17], (DEPTH, D_LRU), 0.01),
        'lru_lambda': jnp.log(a0) - jnp.log1p(-a0),
        'ssd_conv_w': nrm(ks[18], (DEPTH, CONV_W, D_XBC), CONV_W ** -0.5),
        'ssd_conv_b': nrm(ks[19], (DEPTH, D_XBC), 0.01),
        'ssd_dt_bias': dt0 + jnp.log(-jnp.expm1(-dt0)),
        'ssd_a_log': jnp.log(jax.random.uniform(ks[22], (DEPTH, SSD_HEADS), jnp.float32, 1.0, 16.0)),
        'ssd_d': 1.0 + nrm(ks[23], (DEPTH, SSD_HEADS), 0.1),
        'ssd_norm_g': 1.0 + nrm(ks[24], (DEPTH, D_SSD), 0.02),
        'w_out': nrm(ks[25], (DEPTH, D_MIX, D_MODEL), D_MIX ** -0.5),
        'final_norm_g': 1.0 + nrm(ks[26], (D_MODEL,), 0.02),
    }


def reference(x_prompt, x_sample, c_prompt, c_sample, state_lru_conv, state_lru_h,
              state_ssd_conv, state_ssd, norm_g, w_ada, b_ada, w_in, lru_conv_w, lru_conv_b,
              lru_w_a, lru_b_a, lru_w_x, lru_b_x, lru_lambda, ssd_conv_w, ssd_conv_b,
              ssd_dt_bias, ssd_a_log, ssd_d, ssd_norm_g, w_out, final_norm_g):
    xp, xs = x_prompt, x_sample
    bp = xp.shape[0]
    lc_p, lh_p, sc_p, ss_p = [], [], [], []
    lc_s, lh_s, sc_s, ss_s = [], [], [], []
    for l in range(DEPTH):
        p = {'norm_g': norm_g[l], 'w_ada': w_ada[l], 'b_ada': b_ada[l], 'w_in': w_in[l],
             'lru_conv_w': lru_conv_w[l], 'lru_conv_b': lru_conv_b[l],
             'lru_w_a': lru_w_a[l], 'lru_b_a': lru_b_a[l], 'lru_w_x': lru_w_x[l],
             'lru_b_x': lru_b_x[l], 'lru_lambda': lru_lambda[l],
             'ssd_conv_w': ssd_conv_w[l], 'ssd_conv_b': ssd_conv_b[l],
             'ssd_dt_bias': ssd_dt_bias[l], 'ssd_a_log': ssd_a_log[l], 'ssd_d': ssd_d[l],
             'ssd_norm_g': ssd_norm_g[l], 'w_out': w_out[l]}
        xp, a1, a2, a3, a4 = mixer_layer(
            xp, c_prompt,
            jnp.zeros((bp, CONV_W - 1, D_LRU), xp.dtype), jnp.zeros((bp, D_LRU), xp.dtype),
            jnp.zeros((bp, CONV_W - 1, D_XBC), xp.dtype),
            jnp.zeros((bp, SSD_GROUPS, SSD_HPG, SSD_HEAD_DIM, SSD_STATE), xp.dtype),
            0, CHUNK, p)
        xs, b1, b2, b3, b4 = mixer_layer(
            xs, c_sample, state_lru_conv[l], state_lru_h[l], state_ssd_conv[l], state_ssd[l],
            PAST_LEN, xs.shape[1], p)
        lc_p.append(a1); lh_p.append(a2); sc_p.append(a3); ss_p.append(a4)
        lc_s.append(b1); lh_s.append(b2); sc_s.append(b3); ss_s.append(b4)
    y_prompt = rmsnorm(xp, final_norm_g)
    y_sample = rmsnorm(xs, final_norm_g)
    return (y_prompt, y_sample,
            jnp.stack(lc_p), jnp.stack(lh_p), jnp.stack(sc_p), jnp.stack(ss_p),
            jnp.stack(lc_s), jnp.stack(lh_s), jnp.stack(sc_s), jnp.stack(ss_s))
```

```cpp
#include <hip/hip_runtime.h>
#include <hip/hip_cooperative_groups.h>
#include <cstdio>
namespace cg = cooperative_groups;

#ifndef PHASE_MASK
#define PHASE_MASK 0x7f
#endif
#ifndef REP_MASK
#define REP_MASK 0
#endif
#ifndef PROBE_P4
#define PROBE_P4 0
#endif
#ifndef ONE_LAUNCH
#define ONE_LAUNCH 1
#endif

#define LAS __attribute__((address_space(3)))
#define DI __device__ __forceinline__
typedef unsigned short bf16_t;
typedef short bf16x8 __attribute__((ext_vector_type(8)));
typedef float f32x4 __attribute__((ext_vector_type(4)));
typedef float f32x16 __attribute__((ext_vector_type(16)));
typedef unsigned u32x4 __attribute__((ext_vector_type(4)));
typedef unsigned u32x2 __attribute__((ext_vector_type(2)));
typedef __bf16 bf2_t __attribute__((ext_vector_type(2)));
typedef float f2_t __attribute__((ext_vector_type(2)));

constexpr int TP = 65536, TS = 512, MT = TP + TS;
constexpr int LDP = 4608;
constexpr int NPAD = 4864;
constexpr float EPS = 1e-6f;
constexpr size_t O_YP = 0, O_YS = 67108864, O_LCP = O_YS + 524288, O_LHP = O_LCP + 98304, O_SCP = O_LHP + 32768, O_SSP = O_SCP + 147456,
                 O_LCS = O_SSP + 4194304, O_LHS = O_LCS + 49152, O_SCS = O_LHS + 16384, O_SSS = O_SCS + 73728;
constexpr size_t WS_MOD = 0;
constexpr size_t WS_R1 = 1048576;
constexpr size_t WS_WIN = WS_R1 + (size_t)MT * 1024 * 2;
constexpr size_t WS_WOUT = WS_WIN + (size_t)NPAD * 1024 * 2;
constexpr size_t WS_PROJ = WS_WOUT + (size_t)1024 * 2048 * 2;
constexpr size_t WS_DT = WS_PROJ + (size_t)MT * LDP * 2;
constexpr size_t WS_BC = WS_DT + (size_t)MT * 16 * 4;
constexpr size_t WS_BT = WS_BC + (size_t)MT * 512 * 2;
constexpr size_t WS_XT = WS_BT + (size_t)MT * 256 * 2;
constexpr size_t WS_SSQ = WS_XT + (size_t)MT * 1024 * 2;
constexpr size_t WS_PSQ = WS_SSQ + (size_t)MT * 32 * 4;
constexpr size_t WS_CTR = WS_PSQ + (size_t)MT * 16 * 4;
constexpr size_t WS_RS = WS_CTR + 8192;
constexpr size_t WS_DTC = WS_RS + (size_t)MT * 2 * 4;
constexpr size_t WS_WDT = WS_DTC + (size_t)MT * 16 * 2 * 4;
constexpr size_t WS_END = WS_WDT + 16 * 1024 * 2;
constexpr int LDS_BYTES = 131072 + 2048;

struct Params { const float* in[27]; float* out; unsigned char* ws; };

DI unsigned pk2(float a, float b) { f2_t v = {a, b}; return __builtin_bit_cast(unsigned, __builtin_convertvector(v, bf2_t)); }
DI bf16_t f2bf(float a) { return (bf16_t)(pk2(a, 0.f) & 0xffffu); }
DI float bf_lo(unsigned u) { return __uint_as_float(u << 16); }
DI float bf_hi(unsigned u) { return __uint_as_float(u & 0xffff0000u); }
DI float bf2f(bf16_t h) { return __uint_as_float(((unsigned)h) << 16); }
DI float fexp(float x) { return __builtin_amdgcn_exp2f(x * 1.4426950408889634f); }
DI float sigm(float x) { return __builtin_amdgcn_rcpf(1.f + fexp(-x)); }
DI float silu(float x) { return x * __builtin_amdgcn_rcpf(1.f + fexp(-x)); }
DI float one_minus_exp(float x, float ex) { const float ser = -x * (1.f + x * (0.5f + x * (0.16666667f + x * (0.041666668f + x * 0.0083333338f)))); return x > -0.125f ? ser : 1.f - ex; }
DI float softplus(float x) { return x > 20.f ? x : log1pf(fexp(x)); }
DI int tid_of(int wave_s) { return (wave_s << 6) | (int)__builtin_amdgcn_mbcnt_hi(~0u, __builtin_amdgcn_mbcnt_lo(~0u, 0u)); }
DI int crow(int reg, int h) { return (reg & 3) + 8 * (reg >> 2) + 4 * h; }
#define MFMA32(a, b, c) __builtin_amdgcn_mfma_f32_32x32x16_bf16((a), (b), (c), 0, 0, 0)
#define LDS_WAIT() asm volatile("s_waitcnt lgkmcnt(0)" ::: "memory")

namespace g8 {
constexpr int BM = 256, BK = 64, HALF = 128, HTB = HALF * BK * 2, NXCD = 8, WGM = 8;
DI int lds_byte(int r, int c) { const int st = (r >> 4) * 2 + (c >> 5), rr = r & 15, cc = c & 31, ob = rr * 64 + cc * 2; return st * 1024 + (ob ^ (((ob >> 9) & 1) << 5)); }
DI void stage_rc(int b, int& R, int& C) { const int st = b / 1024, sb = b % 1024, swz = sb ^ (((sb >> 9) & 1) << 5); R = (st >> 1) * 16 + swz / 64; C = (st & 1) * 32 + (swz % 64) / 2; }
DI int perm32(int rho) { const int n = rho >> 4, i = rho & 15; return 8 * (i >> 2) + 4 * n + (i & 3); }
struct Unit { int pm, pn, seg; };
DI void tile_of(int wgid, int nM, int nN, int& pm, int& pn) {
    const int nwg = nM * nN, q = nwg / NXCD, r = nwg % NXCD, xcd = wgid % NXCD, off = wgid / NXCD;
    wgid = (xcd < r ? xcd * (q + 1) : r * (q + 1) + (xcd - r) * q) + off;
    const int nig = WGM * nN, gid = wgid / nig, fm = gid * WGM, gsz = (nM - fm) < WGM ? (nM - fm) : WGM;
    pm = fm + ((wgid % nig) % gsz); pn = (wgid % nig) / gsz;
}
struct Gemm { const bf16_t* A; const bf16_t* Bt; int lda, ldb; };

struct SchedIn {
    int nM, nN, G, c;
#if REP_MASK & 4
    DI bool next(int i, Unit& u) const { long L = (long)i * G + c; const long nwg = (long)nM * nN; if (L >= 2 * nwg) return false; if (L >= nwg) L -= nwg; tile_of((int)L, nM, nN, u.pm, u.pn); u.seg = 0; return true; }
#else
    DI bool next(int i, Unit& u) const { const long L = (long)i * G + c; if (L >= (long)nM * nN) return false; tile_of((int)L, nM, nN, u.pm, u.pn); u.seg = 0; return true; }
#endif
    DI int nt(const Unit&) const { return 16; }
    DI size_t aoff(const Unit& u) const { return (size_t)u.pm * 256 * 1024 * 2; }
    DI size_t boff(const Unit& u) const { return (size_t)u.pn * 256 * 1024 * 2; }
    DI bool fresh(const Unit&) const { return true; }
};
struct SchedOut {
    int nM, nN, G, c, pm0;
    DI bool next(int i, Unit& u) const { const int ti = i / 3; u.seg = i - 3 * ti; const long L = (long)ti * G + c; if (c >= G || L >= (long)nM * nN) return false; tile_of((int)L, nM, nN, u.pm, u.pn); u.pm += pm0; return true; }
    DI int nt(const Unit& u) const { return u.seg == 2 ? 16 : 8; }
    DI int kofs(const Unit& u) const { return u.seg == 0 ? 1024 : (u.seg == 1 ? 1536 : 0); }
    DI size_t aoff(const Unit& u) const { return ((size_t)u.pm * 256 * LDP + 1024 + kofs(u)) * 2; }
    DI size_t boff(const Unit& u) const { return ((size_t)u.pn * 256 * 2048 + kofs(u)) * 2; }
    DI bool fresh(const Unit& u) const { return u.seg == 0; }
};

template <class Epi, class Sched>
DI void gemm_phase(LAS unsigned char* lds, const Gemm g, const Sched& S, Epi& E, int wave_s) {
    int tid = tid_of(wave_s); asm volatile("" : "+v"(tid));
    const int wid = __builtin_amdgcn_readfirstlane(tid >> 6), lane = tid & 63, wr = wid >> 2, wc = wid & 3, fr = lane & 15, fq = lane >> 4;
    unsigned voffA[2], voffB[2];
#pragma unroll
    for (int i = 0; i < 2; ++i) { int R, C; stage_rc(tid * 16 + i * 8192, R, C); const int Rb = Epi::PERM ? ((R & ~31) + perm32(R & 31)) : R;
        voffA[i] = (unsigned)(R * g.lda + C) * 2u; voffB[i] = (unsigned)(Rb * g.ldb + C) * 2u; }
    const size_t kstep = (size_t)(BK * 2);
    const size_t hstepA = (size_t)HALF * g.lda * 2, hstepB = (size_t)HALF * g.ldb * 2;
    const unsigned ldsw = (unsigned)wid * 1024u;
    const int aoff = lds_byte(wr * 64 + fr, fq * 8), boff = lds_byte(wc * 32 + fr, fq * 8);
#define PG8_SA(b, h) (((b) * 2 + (h)) * HTB)
#define PG8_SB(b, h) ((4 + (b) * 2 + (h)) * HTB)
#define PG8_STAGE(bufoff, gbase, voff) do { _Pragma("unroll") for (int _i = 0; _i < 2; ++_i) \
        __builtin_amdgcn_global_load_lds((const unsigned*)((const char*)(gbase) + (voff)[_i]), (LAS unsigned*)(lds + (bufoff) + ldsw + _i * 8192), 16, 0, 0); } while (0)
#define PG8_LDA(dst, b, h) do { _Pragma("unroll") for (int m = 0; m < 4; ++m) _Pragma("unroll") for (int k = 0; k < 2; ++k) dst[m][k] = *(const LAS bf16x8*)(lds + PG8_SA(b, h) + aoff + m * 2048 + k * 1024); } while (0)
#define PG8_LDB(dst, b, h) do { _Pragma("unroll") for (int n = 0; n < 2; ++n) _Pragma("unroll") for (int k = 0; k < 2; ++k) dst[n][k] = *(const LAS bf16x8*)(lds + PG8_SB(b, h) + boff + n * 2048 + k * 1024); } while (0)
#define PG8_MMA(ai, bj, At, Bt) do { __builtin_amdgcn_s_setprio(1); _Pragma("unroll") for (int m = 0; m < 4; ++m) _Pragma("unroll") for (int n = 0; n < 2; ++n) _Pragma("unroll") for (int k = 0; k < 2; ++k) \
        acc[ai][bj][m][n] = __builtin_amdgcn_mfma_f32_16x16x32_bf16(Bt[n][k], At[m][k], acc[ai][bj][m][n], 0, 0, 0); __builtin_amdgcn_s_setprio(0); } while (0)
#define PG8_WAIT_V(n) asm volatile("s_waitcnt vmcnt(" #n ")" ::: "memory")
#define PG8_WAIT_L(n) asm volatile("s_waitcnt lgkmcnt(" #n ")" ::: "memory")
#define PG8_BAR __builtin_amdgcn_s_barrier()
#define PG8_SCHED __builtin_amdgcn_sched_barrier(0)
    Unit cur, nxt; int ui = 0;
    if (!S.next(0, cur)) return;
    f32x4 acc[2][2][4][2];
#pragma unroll
    for (int a = 0; a < 2; ++a)
#pragma unroll
        for (int b = 0; b < 2; ++b)
#pragma unroll
            for (int m = 0; m < 4; ++m)
#pragma unroll
                for (int n = 0; n < 2; ++n) acc[a][b][m][n] = (f32x4){0.f, 0.f, 0.f, 0.f};
    bf16x8 At[4][2], B0[2][2], B1[2][2];
    const char* cA = (const char*)g.A + S.aoff(cur); const char* cB = (const char*)g.Bt + S.boff(cur);
    E.begin(cur, wave_s);
    PG8_STAGE(PG8_SB(0, 0), cB, voffB); PG8_STAGE(PG8_SA(0, 0), cA, voffA); PG8_STAGE(PG8_SB(0, 1), cB + hstepB, voffB); PG8_STAGE(PG8_SA(0, 1), cA + hstepA, voffA);
    if (wr == 1) PG8_BAR;
    PG8_WAIT_V(4); PG8_BAR;
    PG8_STAGE(PG8_SB(1, 0), cB + kstep, voffB); PG8_STAGE(PG8_SA(1, 0), cA + kstep, voffA); PG8_STAGE(PG8_SB(1, 1), cB + hstepB + kstep, voffB);
    PG8_WAIT_V(6); PG8_BAR;
    for (;;) {
        const bool has_next = S.next(ui + 1, nxt);
        const int nt = S.nt(cur);
        const char* nA = has_next ? (const char*)g.A + S.aoff(nxt) : cA; const char* nB = has_next ? (const char*)g.Bt + S.boff(nxt) : cB;
        for (int t = 0; t < nt; t += 2) {
            const bool last = (t == nt - 2);
            const char* a1 = cA + (size_t)(t + 1) * kstep;
            const char* a2 = last ? nA : cA + (size_t)(t + 2) * kstep; const char* b2 = last ? nB : cB + (size_t)(t + 2) * kstep;
            const char* a3 = a2 + kstep; const char* b3 = b2 + kstep;
            PG8_LDB(B0, 0, 0); PG8_SCHED; PG8_LDA(At, 0, 0); PG8_STAGE(PG8_SA(1, 1), a1 + hstepA, voffA);
            PG8_WAIT_L(8); PG8_BAR; PG8_WAIT_L(0); PG8_MMA(0, 0, At, B0); PG8_BAR; PG8_SCHED;
            PG8_LDB(B1, 0, 1); PG8_STAGE(PG8_SB(0, 0), b2, voffB);
            PG8_BAR; PG8_WAIT_L(0); PG8_MMA(0, 1, At, B1); PG8_BAR;
            PG8_LDA(At, 0, 1); PG8_STAGE(PG8_SA(0, 0), a2, voffA);
            PG8_BAR; PG8_WAIT_L(0); PG8_MMA(1, 0, At, B0); PG8_BAR; PG8_SCHED;
            PG8_STAGE(PG8_SB(0, 1), b2 + hstepB, voffB);
            PG8_WAIT_V(6); PG8_BAR; PG8_MMA(1, 1, At, B1); PG8_BAR;
            PG8_LDB(B0, 1, 0); PG8_SCHED; PG8_LDA(At, 1, 0); PG8_STAGE(PG8_SA(0, 1), a2 + hstepA, voffA);
            PG8_WAIT_L(8); PG8_BAR; PG8_WAIT_L(0); PG8_MMA(0, 0, At, B0); PG8_BAR; PG8_SCHED;
            PG8_LDB(B1, 1, 1); PG8_STAGE(PG8_SB(1, 0), b3, voffB);
            PG8_BAR; PG8_WAIT_L(0); PG8_MMA(0, 1, At, B1); PG8_BAR;
            PG8_LDA(At, 1, 1); PG8_STAGE(PG8_SA(1, 0), a3, voffA);
            PG8_BAR; PG8_WAIT_L(0); PG8_MMA(1, 0, At, B0); PG8_BAR; PG8_SCHED;
            PG8_STAGE(PG8_SB(1, 1), b3 + hstepB, voffB);
            PG8_WAIT_V(6); PG8_BAR; PG8_MMA(1, 1, At, B1); PG8_BAR;
        }
        E(acc, cur, nxt, has_next, wave_s, wr, wc, fr, fq);
        if (!has_next) break;
        if (S.fresh(nxt)) {
#pragma unroll
            for (int a = 0; a < 2; ++a)
#pragma unroll
                for (int b = 0; b < 2; ++b)
#pragma unroll
                    for (int m = 0; m < 4; ++m)
#pragma unroll
                        for (int n = 0; n < 2; ++n) acc[a][b][m][n] = (f32x4){0.f, 0.f, 0.f, 0.f};
        }
        cur = nxt; cA = nA; cB = nB; ++ui;
    }
    PG8_WAIT_V(0);
    if (wr == 0) PG8_BAR;
    PG8_BAR;
#undef PG8_SA
#undef PG8_SB
#undef PG8_STAGE
#undef PG8_LDA
#undef PG8_LDB
#undef PG8_MMA
#undef PG8_WAIT_V
#undef PG8_WAIT_L
#undef PG8_BAR
#undef PG8_SCHED
}

struct EpiProj {
    static constexpr bool PERM = true;
    bf16_t* O; float* dt;
    DI void begin(const Unit&, int) {}
    DI void operator()(f32x4 (&acc)[2][2][4][2], const Unit& u, const Unit&, bool, int, int wr, int wc, int fr, int fq) const {
        const int row0 = u.pm * BM + wr * 64 + fr;
        if (u.pn == 18) {
            if (wc == 0 && fq < 2) {
#pragma unroll
                for (int ai = 0; ai < 2; ++ai)
#pragma unroll
                    for (int m = 0; m < 4; ++m) { float* rp = dt + (size_t)(row0 + ai * HALF + m * 16) * 16 + 8 * fq;
                        *(f32x4*)(rp) = acc[ai][0][m][0]; *(f32x4*)(rp + 4) = acc[ai][0][m][1]; }
            }
            return;
        }
        const int col0 = u.pn * BM + wc * 32 + 8 * fq;
#pragma unroll
        for (int ai = 0; ai < 2; ++ai)
#pragma unroll
            for (int m = 0; m < 4; ++m) { bf16_t* rowp = O + (size_t)(row0 + ai * HALF + m * 16) * LDP + col0;
#pragma unroll
                for (int bj = 0; bj < 2; ++bj) { const f32x4 v0 = acc[ai][bj][m][0], v1 = acc[ai][bj][m][1];
                    u32x4 w; w.x = pk2(v0[0], v0[1]); w.y = pk2(v0[2], v0[3]); w.z = pk2(v1[0], v1[1]); w.w = pk2(v1[2], v1[3]);
                    *(u32x4*)(rowp + bj * HALF) = w; } }
    }
};
struct EpiOut {
    static constexpr bool PERM = true;
    const float* ssq; const float* xp; const float* xs; const float* mod; bf16_t* outp; float* psq; int dummy;
    LAS unsigned char* fl;
    DI void load_sc(const Unit& u, int wave_s) {
        const int tid = tid_of(wave_s);
        if (tid < 256) {
            const f32x4* q = (const f32x4*)(ssq + (size_t)(u.pm * BM + tid) * 32);
            const f32x4 a = (q[0] + q[1]) + (q[2] + q[3]), b = (q[4] + q[5]) + (q[6] + q[7]);
            const float s0 = (a[0] + a[1]) + (a[2] + a[3]), s1 = (b[0] + b[1]) + (b[2] + b[3]);
            const float r0 = rsqrtf(s0 * (1.f / 512.f) + EPS), r1 = rsqrtf(s1 * (1.f / 512.f) + EPS);
            f2_t o; o[0] = r0 / r1; o[1] = r1; *(LAS f2_t*)(fl + tid * 8) = o; }
    }
    DI void begin(const Unit& u, int wave_s) { load_sc(u, wave_s); }
    DI void operator()(f32x4 (&acc)[2][2][4][2], const Unit& u, const Unit& nxt, bool has_next, int wave_s, int wr, int wc, int fr, int fq) {
        if (PROBE_P4 && dummy) return;
        const int row0 = u.pm * BM + wr * 64 + fr;
        if (u.seg < 2) {
#pragma unroll
            for (int ai = 0; ai < 2; ++ai)
#pragma unroll
                for (int m = 0; m < 4; ++m) { const f2_t fv = *(const LAS f2_t*)(fl + (wr * 64 + fr + ai * HALF + m * 16) * 8); const float f = u.seg == 0 ? fv[0] : fv[1];
#pragma unroll
                    for (int bj = 0; bj < 2; ++bj)
#pragma unroll
                        for (int n = 0; n < 2; ++n) acc[ai][bj][m][n] = acc[ai][bj][m][n] * f; }
            return;
        }
        if (has_next) load_sc(nxt, wave_s);
        const int col0 = u.pn * BM + wc * 32 + 8 * fq;
        if (u.pm < TP / 256) {
            const float* gate = mod + (size_t)(u.pm >> 3) * 3072 + 2048 + col0;
            const f32x4 g00 = *(const f32x4*)(gate), g01 = *(const f32x4*)(gate + 4), g10 = *(const f32x4*)(gate + HALF), g11 = *(const f32x4*)(gate + HALF + 4);
#pragma unroll
            for (int ai = 0; ai < 2; ++ai) {
                f32x4 xv[4][4];
#pragma unroll
                for (int m = 0; m < 4; ++m) { const float* xrow = xp + (size_t)(row0 + ai * HALF + m * 16) * 1024 + col0;
                    xv[m][0] = *(const f32x4*)(xrow); xv[m][1] = *(const f32x4*)(xrow + 4); xv[m][2] = *(const f32x4*)(xrow + HALF); xv[m][3] = *(const f32x4*)(xrow + HALF + 4); }
#pragma unroll
                for (int m = 0; m < 4; ++m) { const int row = row0 + ai * HALF + m * 16;
                    const f32x4 v0 = xv[m][0] + g00 * acc[ai][0][m][0], v1 = xv[m][1] + g01 * acc[ai][0][m][1], v2 = xv[m][2] + g10 * acc[ai][1][m][0], v3 = xv[m][3] + g11 * acc[ai][1][m][1];
                    float ss = (v0[0] * v0[0] + v0[1] * v0[1]) + (v0[2] * v0[2] + v0[3] * v0[3]) + (v1[0] * v1[0] + v1[1] * v1[1]) + (v1[2] * v1[2] + v1[3] * v1[3])
                             + (v2[0] * v2[0] + v2[1] * v2[1]) + (v2[2] * v2[2] + v2[3] * v2[3]) + (v3[0] * v3[0] + v3[1] * v3[1]) + (v3[2] * v3[2] + v3[3] * v3[3]);
                    u32x4 w; w.x = pk2(v0[0], v0[1]); w.y = pk2(v0[2], v0[3]); w.z = pk2(v1[0], v1[1]); w.w = pk2(v1[2], v1[3]);
                    *(u32x4*)(outp + (size_t)row * 1024 + col0) = w;
                    w.x = pk2(v2[0], v2[1]); w.y = pk2(v2[2], v2[3]); w.z = pk2(v3[0], v3[1]); w.w = pk2(v3[2], v3[3]);
                    *(u32x4*)(outp + (size_t)row * 1024 + col0 + HALF) = w;
                    ss += __shfl_xor(ss, 16); ss += __shfl_xor(ss, 32);
                    if (fq == 0) psq[(size_t)row * 16 + u.pn * 4 + wc] = ss; }
            }
            return;
        }
#pragma unroll
        for (int ai = 0; ai < 2; ++ai)
#pragma unroll
            for (int m = 0; m < 4; ++m) { const int row = row0 + ai * HALF + m * 16;
                const int bb = 32 + ((row - TP) >> 5);
                const float* xrow = xs + (size_t)(row - TP) * 1024;
                const float* gate = mod + (size_t)bb * 3072 + 2048;
                float ss = 0.f;
#pragma unroll
                for (int bj = 0; bj < 2; ++bj) { const int c = col0 + bj * HALF;
                    const f32x4 x0 = *(const f32x4*)(xrow + c), x1 = *(const f32x4*)(xrow + c + 4);
                    const f32x4 g0 = *(const f32x4*)(gate + c), g1 = *(const f32x4*)(gate + c + 4);
                    const f32x4 v0 = x0 + g0 * acc[ai][bj][m][0], v1 = x1 + g1 * acc[ai][bj][m][1];
                    ss += (v0[0] * v0[0] + v0[1] * v0[1]) + (v0[2] * v0[2] + v0[3] * v0[3]) + (v1[0] * v1[0] + v1[1] * v1[1]) + (v1[2] * v1[2] + v1[3] * v1[3]);
                    u32x4 w; w.x = pk2(v0[0], v0[1]); w.y = pk2(v0[2], v0[3]); w.z = pk2(v1[0], v1[1]); w.w = pk2(v1[2], v1[3]);
                    *(u32x4*)(outp + (size_t)row * 1024 + c) = w; }
                ss += __shfl_xor(ss, 16); ss += __shfl_xor(ss, 32);
                if (fq == 0) psq[(size_t)row * 16 + u.pn * 4 + wc] = ss; }
    }
};
}

DI void tr_item(const float* W, int N, bf16_t* WT, int ldt, LAS float* scr, int kb, int nb, int lane, const float* kscale, int kscale_from) {
    const int k0 = 64 * kb, n0 = 32 * nb;
#pragma unroll 8
    for (int i = 0; i < 32; ++i) { const int kk = 2 * i + (lane >> 5), n = n0 + (lane & 31);
        float v = (n < N) ? W[(size_t)(k0 + kk) * N + n] : 0.f;
        if (kscale && (k0 + kk) >= kscale_from) v *= kscale[k0 + kk - kscale_from];
        scr[kk * 33 + (lane & 31)] = v; }
    LDS_WAIT();
    const int c = lane & 7;
#pragma unroll
    for (int j = 0; j < 4; ++j) { const int n = (lane >> 3) + 8 * j; const LAS float* s = scr + (8 * c) * 33 + n;
        u32x4 o; o.x = pk2(s[0 * 33], s[1 * 33]); o.y = pk2(s[2 * 33], s[3 * 33]); o.z = pk2(s[4 * 33], s[5 * 33]); o.w = pk2(s[6 * 33], s[7 * 33]);
        *(u32x4*)(WT + (size_t)(n0 + n) * ldt + k0 + 8 * c) = o; }
    LDS_WAIT();
}
DI void phase0(const Params& p, LAS unsigned char* lds, int wave_s) {
    int tid = tid_of(wave_s); asm volatile("" : "+v"(tid));
    const int lane = tid & 63, wave = __builtin_amdgcn_readfirstlane(tid >> 6);
    float* mod = (float*)(p.ws + WS_MOD);
    { bf16_t* wdt = (bf16_t*)(p.ws + WS_WDT);
      for (int i = blockIdx.x * 512 + tid; i < 16384; i += gridDim.x * 512) { const int n = i & 15, k = i >> 4; wdt[n * 1024 + k] = f2bf(p.in[11][(size_t)k * 4624 + 4608 + n]); } }
    for (int it = blockIdx.x; it < 288; it += gridDim.x) {
        const int rg = it / 48, cb = it % 48;
        LAS float* sc = (LAS float*)lds;
        LAS float* part = (LAS float*)(lds + 32768);
        for (int i = tid; i < 8192; i += 512) { const int r = i >> 10, k = i & 1023, bb = 8 * rg + r;
            const float c = bb < 32 ? p.in[2][bb * 1024 + k] : p.in[3][(bb - 32) * 1024 + k]; sc[i] = silu(c); }
        __syncthreads();
        const float* W = p.in[9] + (size_t)(128 * wave) * 3072 + cb * 64 + lane;
        float a[8] = {0.f, 0.f, 0.f, 0.f, 0.f, 0.f, 0.f, 0.f};
#pragma unroll 4
        for (int k4 = 0; k4 < 32; ++k4) {
            const float w0 = W[(size_t)(4 * k4 + 0) * 3072], w1 = W[(size_t)(4 * k4 + 1) * 3072], w2 = W[(size_t)(4 * k4 + 2) * 3072], w3 = W[(size_t)(4 * k4 + 3) * 3072];
#pragma unroll
            for (int r = 0; r < 8; ++r) { const f32x4 s4 = *(const LAS f32x4*)(sc + r * 1024 + 128 * wave + 4 * k4); a[r] += (s4[0] * w0 + s4[1] * w1) + (s4[2] * w2 + s4[3] * w3); } }
#pragma unroll
        for (int r = 0; r < 8; ++r) part[(wave * 8 + r) * 64 + lane] = a[r];
        __syncthreads();
        { const int r = tid >> 6, c = tid & 63; float v = p.in[10][cb * 64 + c];
#pragma unroll
          for (int w = 0; w < 8; ++w) v += part[(w * 8 + r) * 64 + c];
          mod[(size_t)(8 * rg + r) * 3072 + cb * 64 + c] = v; }
        __syncthreads();
    }
}

DI float wave_sum(float v) {
#pragma unroll
    for (int o = 1; o < 64; o <<= 1) v += __shfl_xor(v, o);
    return v;
}
DI void norm_row(const float* xrow, bf16_t* orow, const f32x4 (&gs)[4], const f32x4 (&sh)[4], int lane, LAS unsigned char* arow) {
    f32x4 v[4]; float s = 0.f;
#pragma unroll
    for (int j = 0; j < 4; ++j) { v[j] = *(const f32x4*)(xrow + 4 * lane + 256 * j); s += (v[j][0] * v[j][0] + v[j][1] * v[j][1]) + (v[j][2] * v[j][2] + v[j][3] * v[j][3]); }
    const float rstd = rsqrtf(wave_sum(s) * (1.f / 1024.f) + EPS);
#pragma unroll
    for (int j = 0; j < 4; ++j) { const f32x4 o = v[j] * rstd * gs[j] + sh[j]; u32x2 w; w.x = pk2(o[0], o[1]); w.y = pk2(o[2], o[3]);
        *(u32x2*)(orow + 4 * lane + 256 * j) = w; *(LAS u32x2*)(arow + (4 * lane + 256 * j) * 2) = w; }
}
DI void phase1(const Params& p, LAS unsigned char* lds, int wave_s) {
    int tid = tid_of(wave_s); asm volatile("" : "+v"(tid));
    const int lane = tid & 63, wave = __builtin_amdgcn_readfirstlane(tid >> 6);
    const int gw = blockIdx.x * 8 + wave, NGW = gridDim.x * 8;
    const float* mod = (const float*)(p.ws + WS_MOD);
    bf16_t* hn = (bf16_t*)(p.ws + WS_R1);
    f32x4 g4[4];
#pragma unroll
    for (int j = 0; j < 4; ++j) g4[j] = *(const f32x4*)(p.in[8] + 4 * lane + 256 * j);
    LAS unsigned char* arow = lds + wave * 8448;
    LAS unsigned char* wdl = lds + 67584;
    float* DT = (float*)(p.ws + WS_DT);
    { const u32x4* src = (const u32x4*)(p.ws + WS_WDT);
      for (int i = tid; i < 2048; i += 512) *(LAS u32x4*)(wdl + (i >> 7) * 2064 + (i & 127) * 16) = src[i];
      __syncthreads(); }
#define DT_STEP(nrows, row) do { LDS_WAIT(); f32x4 dacc = {0.f, 0.f, 0.f, 0.f}; \
        _Pragma("unroll 8") for (int kk = 0; kk < 32; ++kk) { \
            const bf16x8 fa = *(const LAS bf16x8*)(arow + (lane & 3) * 2064 + (32 * kk + 8 * (lane >> 4)) * 2); \
            const bf16x8 fb = *(const LAS bf16x8*)(wdl + (lane & 15) * 2064 + (32 * kk + 8 * (lane >> 4)) * 2); \
            dacc = __builtin_amdgcn_mfma_f32_16x16x32_bf16(fa, fb, dacc, 0, 0, 0); } \
        if (lane < 16) { _Pragma("unroll") for (int i = 0; i < (nrows); ++i) DT[((row) + i) * 16 + lane] = dacc[i]; } \
        LDS_WAIT(); } while (0)
    for (int rw = gw; rw < 2048 + 512; rw += NGW) {
        const bool samp = rw >= 2048;
        const int bb = samp ? 32 + ((rw - 2048) >> 5) : (rw >> 6);
        const float* mb = mod + (size_t)bb * 3072;
        f32x4 gs[4], sh[4];
#pragma unroll
        for (int j = 0; j < 4; ++j) { const f32x4 scl = *(const f32x4*)(mb + 1024 + 4 * lane + 256 * j); gs[j] = g4[j] * (scl + 1.f); sh[j] = *(const f32x4*)(mb + 4 * lane + 256 * j); }
        if (samp) { const int r = rw - 2048; norm_row(p.in[1] + (size_t)r * 1024, hn + (size_t)(TP + r) * 1024, gs, sh, lane, arow); DT_STEP(1, (size_t)(TP + r)); }
        else for (int r = 0; r < 32; r += 4) { const size_t row = (size_t)rw * 32 + r;
            const float* xr = p.in[0] + row * 1024 + 4 * lane; bf16_t* orow = hn + row * 1024 + 4 * lane;
            f32x4 v[4][4]; float s[4];
#pragma unroll
            for (int i = 0; i < 4; ++i)
#pragma unroll
                for (int j = 0; j < 4; ++j) v[i][j] = *(const f32x4*)(xr + i * 1024 + 256 * j);
#pragma unroll
            for (int i = 0; i < 4; ++i) { s[i] = 0.f;
#pragma unroll
                for (int j = 0; j < 4; ++j) s[i] += (v[i][j][0] * v[i][j][0] + v[i][j][1] * v[i][j][1]) + (v[i][j][2] * v[i][j][2] + v[i][j][3] * v[i][j][3]); }
#pragma unroll
            for (int o = 1; o < 64; o <<= 1) {
#pragma unroll
                for (int i = 0; i < 4; ++i) s[i] += __shfl_xor(s[i], o); }
#pragma unroll
            for (int i = 0; i < 4; ++i) { const float rstd = rsqrtf(s[i] * (1.f / 1024.f) + EPS);
#pragma unroll
                for (int j = 0; j < 4; ++j) { const f32x4 o = v[i][j] * rstd * gs[j] + sh[j]; u32x2 w; w.x = pk2(o[0], o[1]); w.y = pk2(o[2], o[3]);
                    *(u32x2*)(orow + i * 1024 + 256 * j) = w; *(LAS u32x2*)(arow + i * 2064 + (4 * lane + 256 * j) * 2) = w; } }
            DT_STEP(4, row); }
    }
#undef DT_STEP
    __syncthreads();
    LAS float* scr = (LAS float*)(lds + wave * 8448);
    constexpr int I_IN = 16 * 144, I_OUT = 32 * 32;
    for (int it = gw; it < I_IN + I_OUT; it += NGW) {
        if (it < I_IN) tr_item(p.in[11], 4624, (bf16_t*)(p.ws + WS_WIN), 1024, scr, it / 144, it % 144, lane, nullptr, 0);
        else { const int r = it - I_IN; tr_item(p.in[25], 1024, (bf16_t*)(p.ws + WS_WOUT), 2048, scr, r / 32, r % 32, lane, p.in[24], 1024); }
    }
}

DI void unpack8(const u32x4 v, float (&o)[8]) { o[0] = bf_lo(v.x); o[1] = bf_hi(v.x); o[2] = bf_lo(v.y); o[3] = bf_hi(v.y); o[4] = bf_lo(v.z); o[5] = bf_hi(v.z); o[6] = bf_lo(v.w); o[7] = bf_hi(v.w); }
DI void conv_group(const Params& p, const u32x4 (&raw)[8], float (&h0)[8], float (&h1)[8], float (&h2)[8], const float (&w0)[8], const float (&w1)[8], const float (&w2)[8],
                   const float (&w3)[8], const float (&bias)[8], int row0, int t0, bool lru, int c0, int cx, LAS bf16_t* T) {
    bf16_t* U = (bf16_t*)(p.ws + WS_R1);
    bf16_t* BC = (bf16_t*)(p.ws + WS_BC);
    bf16_t* XC = (bf16_t*)(p.ws + WS_XT);
#pragma unroll
    for (int ti = 0; ti < 8; ++ti) {
        float cur[8], o[8];
        unpack8(raw[ti], cur);
#pragma unroll
        for (int i = 0; i < 8; ++i) { o[i] = bias[i] + w0[i] * h0[i] + w1[i] * h1[i] + w2[i] * h2[i] + w3[i] * cur[i]; h0[i] = h1[i]; h1[i] = h2[i]; h2[i] = cur[i]; }
        u32x4 w;
        if (lru) { w.x = pk2(o[0], o[1]); w.y = pk2(o[2], o[3]); w.z = pk2(o[4], o[5]); w.w = pk2(o[6], o[7]);
            *(u32x4*)(U + ((unsigned)(row0 + ti) * 1024u + (unsigned)c0)) = w; }
        else { w.x = pk2(silu(o[0]), silu(o[1])); w.y = pk2(silu(o[2]), silu(o[3])); w.z = pk2(silu(o[4]), silu(o[5])); w.w = pk2(silu(o[6]), silu(o[7]));
            if (cx < 1024) *(u32x4*)(XC + ((unsigned)(row0 + ti) * 1024u + (unsigned)cx)) = w;
            else { const int cg = cx - 1024, off = cg & 15;
                const unsigned d = (unsigned)(row0 + ti) * 512u + (unsigned)((cg & ~15) + (off >> 1));
                u32x2 lo, hi; lo.x = w.x; lo.y = w.y; hi.x = w.z; hi.y = w.w;
                *(u32x2*)(BC + d) = lo; *(u32x2*)(BC + (d + 8u)) = hi;
                if (cg < 256) *(LAS u32x4*)(T + (t0 + ti) * 256 + cg) = w; } }
    }
}
DI void phase2b(const Params& p, LAS unsigned char* lds, int wave_s) {
    int tid = tid_of(wave_s); asm volatile("" : "+v"(tid));
    const bf16_t* proj = (const bf16_t*)(p.ws + WS_PROJ);
    for (int job = 0; job < 2; ++job) {
        for (int bi = blockIdx.x; bi < (job == 0 ? 256 : 16); bi += gridDim.x) {
            const bool samp = job == 1;
            const int rbase = samp ? TP + bi * 32 : bi * 256;
            const int nch = samp ? 1 : 8;
            const bool first = samp || ((bi & 7) == 0);
            if (tid < 320) {
                const int c0 = tid * 8;
                const bool lru = c0 < 1024;
                const int cx = c0 - 1024;
                const int pcol = lru ? c0 : 2048 + cx;
                const float* cw = lru ? p.in[12] + c0 : p.in[19] + cx; const int cwld = lru ? 1024 : 1536;
                const float* cbp = lru ? p.in[13] + c0 : p.in[20] + cx;
                float w0[8], w1[8], w2[8], w3[8], bias[8];
                { f32x4 a, b;
                  a = *(const f32x4*)(cw); b = *(const f32x4*)(cw + 4);
#pragma unroll
                  for (int i = 0; i < 4; ++i) { w0[i] = a[i]; w0[4 + i] = b[i]; }
                  a = *(const f32x4*)(cw + cwld); b = *(const f32x4*)(cw + cwld + 4);
#pragma unroll
                  for (int i = 0; i < 4; ++i) { w1[i] = a[i]; w1[4 + i] = b[i]; }
                  a = *(const f32x4*)(cw + 2 * cwld); b = *(const f32x4*)(cw + 2 * cwld + 4);
#pragma unroll
                  for (int i = 0; i < 4; ++i) { w2[i] = a[i]; w2[4 + i] = b[i]; }
                  a = *(const f32x4*)(cw + 3 * cwld); b = *(const f32x4*)(cw + 3 * cwld + 4);
#pragma unroll
                  for (int i = 0; i < 4; ++i) { w3[i] = a[i]; w3[4 + i] = b[i]; }
                  a = *(const f32x4*)(cbp); b = *(const f32x4*)(cbp + 4);
#pragma unroll
                  for (int i = 0; i < 4; ++i) { bias[i] = a[i]; bias[4 + i] = b[i]; } }
                float h0[8], h1[8], h2[8];
                if (!first) { unpack8(*(const u32x4*)(proj + (size_t)(rbase - 3) * LDP + pcol), h0); unpack8(*(const u32x4*)(proj + (size_t)(rbase - 2) * LDP + pcol), h1);
                    unpack8(*(const u32x4*)(proj + (size_t)(rbase - 1) * LDP + pcol), h2); }
                else if (samp) { const float* st = lru ? p.in[4] + (size_t)bi * 3 * 1024 + c0 : p.in[6] + (size_t)bi * 3 * 1536 + cx;
#pragma unroll
                    for (int i = 0; i < 8; ++i) { h0[i] = st[i]; h1[i] = st[cwld + i]; h2[i] = st[2 * cwld + i]; } }
                else {
#pragma unroll
                    for (int i = 0; i < 8; ++i) { h0[i] = 0.f; h1[i] = 0.f; h2[i] = 0.f; } }
                u32x4 ra[8], rb[8];
                const unsigned so = (unsigned)rbase * (unsigned)LDP + (unsigned)pcol;
#define LD8(dst, r) do { _Pragma("unroll") for (int i = 0; i < 8; ++i) dst[i] = *(const u32x4*)(proj + (so + (unsigned)((r) + i) * (unsigned)LDP)); } while (0)
                LD8(ra, 0);
                for (int c = 0; c < nch; ++c) {
                    __syncthreads();
                    LAS bf16_t* T = (LAS bf16_t*)(lds + (c & 1) * 16384);
                    const int row0 = rbase + 32 * c;
                    LD8(rb, 32 * c + 8);
                    conv_group(p, ra, h0, h1, h2, w0, w1, w2, w3, bias, row0, 0, lru, c0, cx, T);
                    LD8(ra, 32 * c + 16);
                    conv_group(p, rb, h0, h1, h2, w0, w1, w2, w3, bias, row0 + 8, 8, lru, c0, cx, T);
                    LD8(rb, 32 * c + 24);
                    conv_group(p, ra, h0, h1, h2, w0, w1, w2, w3, bias, row0 + 16, 16, lru, c0, cx, T);
                    if (c + 1 < nch) LD8(ra, 32 * c + 32);
                    conv_group(p, rb, h0, h1, h2, w0, w1, w2, w3, bias, row0 + 24, 24, lru, c0, cx, T);
                }
#undef LD8
                __syncthreads();
            } else {
                const int ct = tid - 320;
                const int hw = ct >> 5, t = ct & 31;
                bf16_t* BT = (bf16_t*)(p.ws + WS_BT);
                for (int c = 0; c <= nch; ++c) {
                    __syncthreads();
                    if (c < nch) {
                        const int r0 = rbase + 32 * c, ci = r0 >> 5;
                        for (int hd = hw; hd < 16; hd += 6) {
                            const float dtv = softplus(((const float*)(p.ws + WS_DT))[(size_t)(r0 + t) * 16 + hd] + p.in[21][hd]);
                            float acs = dtv * (-expf(p.in[22][hd]));
#pragma unroll
                            for (int o = 1; o < 32; o <<= 1) { const float v = __shfl_up(acs, o, 32); if (t >= o) acs += v; }
                            f2_t o2; o2[0] = dtv; o2[1] = acs * 1.4426950408889634f;
                            *(f2_t*)((float*)(p.ws + WS_DTC) + (((size_t)ci * 16 + hd) * 32 + t) * 2) = o2; } }
                    if (c >= 1) {
                        const LAS bf16_t* T = (const LAS bf16_t*)(lds + ((c - 1) & 1) * 16384);
                        const int ci = (rbase + 32 * (c - 1)) >> 5;
                        for (int cxx = ct; cxx < 256; cxx += 192) {
                            unsigned wv[16];
#pragma unroll
                            for (int wd = 0; wd < 16; ++wd) { const int pos = 2 * wd, ks = pos >> 4, h = (pos >> 3) & 1, j = pos & 7, s = 16 * ks + 8 * (j >> 2) + 4 * h + (j & 3);
                                const unsigned lo = T[s * 256 + cxx], hi = T[(s + 1) * 256 + cxx]; wv[wd] = lo | (hi << 16); }
                            bf16_t* d = BT + ((size_t)ci * 256 + cxx) * 32;
#pragma unroll
                            for (int i = 0; i < 4; ++i) { u32x4 o; o.x = wv[4 * i]; o.y = wv[4 * i + 1]; o.z = wv[4 * i + 2]; o.w = wv[4 * i + 3]; *(u32x4*)(d + 8 * i) = o; } } }
                }
                if (samp || (bi & 7) == 7) {
                    const int b = samp ? bi : (bi >> 3);
                    const size_t rlast = (size_t)rbase + 32 * nch - 3;
                    for (int i = ct; i < 3 * 2560; i += 192) { const int hr = i / 2560, c = i % 2560; const size_t row = rlast + hr;
                        if (c < 1024) { const float v = bf2f(proj[row * LDP + c]); p.out[(samp ? O_LCS : O_LCP) + ((size_t)b * 3 + hr) * 1024 + c] = v; }
                        else { const int cx = c - 1024; const float v = bf2f(proj[row * LDP + 2048 + cx]); p.out[(samp ? O_SCS : O_SCP) + ((size_t)b * 3 + hr) * 1536 + cx] = v; } }
                }
            }
        }
    }
    __syncthreads();
}

DI bf16x8 pack8(float a0, float a1, float a2, float a3, float a4, float a5, float a6, float a7) {
    u32x4 w; w.x = pk2(a0, a1); w.y = pk2(a2, a3); w.z = pk2(a4, a5); w.w = pk2(a6, a7); return __builtin_bit_cast(bf16x8, w);
}
constexpr int P3_BT = 0, P3_CT = 8192, P3_BTT = 16384, P3_UT = 24576, P3_X = 32768, P3_Z = 40960, P3_G = 49152, P3_BUF = 57344;
DI void glds16(const void* g, LAS unsigned char* l) { __builtin_amdgcn_global_load_lds((const unsigned*)g, (LAS unsigned*)l, 16, 0, 0); }
DI bf16x8 frag_of(const f32x16& v, int k) { f32x4 t; t[0] = v[4 * k]; t[1] = v[4 * k + 1]; t[2] = v[4 * k + 2]; t[3] = v[4 * k + 3]; return __builtin_bit_cast(bf16x8, t); }

DI void p3_stage(const Params& p, LAS unsigned char* buf, int wave, int lane, int rb, int ci, int h, int g, int hd0) {
    asm volatile("" : "+v"(lane));
    const bf16_t* U = (const bf16_t*)(p.ws + WS_R1);
    const bf16_t* proj = (const bf16_t*)(p.ws + WS_PROJ);
    const bf16_t* BC = (const bf16_t*)(p.ws + WS_BC);
    const bf16_t* BT = (const bf16_t*)(p.ws + WS_BT);
    const bf16_t* XT = (const bf16_t*)(p.ws + WS_XT);
    if (wave < 4) {
        const int q = wave;
#pragma unroll
        for (int kk = 0; kk < 2; ++kk) { const int k = 2 * q + kk, r = 4 * k + (lane >> 4), pc = (lane & 15) ^ (r & 15);
            glds16(U + ((unsigned)(rb + r) * 1024u + (unsigned)(h * 128 + pc * 8)), buf + P3_UT + k * 1024); }
#pragma unroll
        for (int k = 0; k < 2; ++k) { const int r = 16 * k + (lane >> 2), pc = lane & 3;
            glds16(proj + ((unsigned)(rb + r) * (unsigned)LDP + (unsigned)(1024 + h * 128 + 32 * q + pc * 8)), buf + P3_G + q * 2048 + k * 1024); }
    } else {
        const int w = wave - 4, hd = hd0 + (w >> 1), ph = w & 1, pch0 = hd * 64 + ph * 32;
#pragma unroll
        for (int kk = 0; kk < 2; ++kk) { const int k = 2 * w + kk, r = 4 * k + (lane >> 4), pc = (lane & 15) ^ (r & 15);
            glds16(BC + ((unsigned)(rb + r) * 512u + (unsigned)(g * 128 + pc * 8)), buf + P3_BT + k * 1024);
            glds16(BC + ((unsigned)(rb + r) * 512u + (unsigned)(256 + g * 128 + pc * 8)), buf + P3_CT + k * 1024);
            const int n = 16 * k + (lane >> 2), pc3 = (lane & 3) ^ ((n >> 2) & 3);
            glds16(BT + (((unsigned)ci * 256u + (unsigned)(g * 128 + n)) * 32u + (unsigned)(pc3 * 8)), buf + P3_BTT + k * 1024); }
#pragma unroll
        for (int k = 0; k < 2; ++k) { const int r = 16 * k + (lane >> 2);
            glds16(XT + ((unsigned)(rb + r) * 1024u + (unsigned)(pch0 + (lane & 3) * 8)), buf + P3_X + w * 2048 + k * 1024);
            glds16(proj + ((unsigned)(rb + r) * (unsigned)LDP + (unsigned)(3584 + pch0 + (lane & 3) * 8)), buf + P3_Z + w * 2048 + k * 1024); }
    }
}

DI void lru_chunk(const Params& p, LAS unsigned char* buf, const f32x16 (&st)[4], float& hc, int posc, int q, float ba, float bx, float c8, int lane) {
    asm volatile("" : "+v"(lane));
    const int j = lane & 31, half = lane >> 5;
    LAS unsigned char* ut = buf + P3_UT;
    LAS unsigned char* gt = buf + P3_G + q * 2048;
    const int pj = 16 * ((j >> 2) & 1) + 4 * (j >> 3) + (j & 3);
    f32x16 aR, aI;
#pragma unroll
    for (int i = 0; i < 16; ++i) { aR[i] = 0.f; aI[i] = 0.f; }
#pragma unroll
    for (int s = 0; s < 8; ++s) { const bf16x8 ua = *(const LAS bf16x8*)(ut + pj * 256 + (((2 * s + half) ^ (pj & 15)) * 16));
        aR = MFMA32(ua, frag_of(st[s >> 2], s & 3), aR); aI = MFMA32(ua, frag_of(st[2 + (s >> 2)], s & 3), aI); }
    float av[16], bv[16];
#pragma unroll
    for (int reg = 0; reg < 16; ++reg) { const int t = 16 * half + reg;
        const float u = bf2f(*(const LAS bf16_t*)(ut + t * 256 + (((4 * q + (j >> 3)) ^ (t & 15)) * 16) + (j & 7) * 2));
        const float r = __builtin_amdgcn_rcpf(1.f + __builtin_amdgcn_exp2f(__builtin_fmaf(aR[reg], -1.4426950408889634f, ba)));
        const float ii = __builtin_amdgcn_rcpf(1.f + __builtin_amdgcn_exp2f(__builtin_fmaf(aI[reg], -1.4426950408889634f, bx)));
        const float a = __builtin_amdgcn_exp2f(c8 * r);
        float mult = __builtin_amdgcn_sqrtf(__builtin_fmaf(-a, a, 1.f));
        if (reg == 0) mult = (posc == 0 && half == 0) ? 1.f : mult;
        av[reg] = a; bv[reg] = mult * ii * u; }
#pragma unroll
    for (int r = 1; r < 16; ++r) { bv[r] = av[r] * bv[r - 1] + bv[r]; av[r] = av[r] * av[r - 1]; }
    const float ho0 = av[15] * hc + bv[15];
    const float sh0 = __shfl(ho0, j);
    const float hin = half ? sh0 : hc;
    const float ho1 = av[15] * hin + bv[15];
    hc = __shfl(ho1, j + 32);
#pragma unroll
    for (int reg = 0; reg < 16; ++reg) { const int t = 16 * half + reg;
        const float hv = av[reg] * hin + bv[reg];
        LAS bf16_t* gp = (LAS bf16_t*)(gt + t * 64 + j * 2);
        const float g = bf2f(*gp);
        *gp = f2bf(hv * silu(g)); }
}
DI void lru_flush(const Params& p, LAS unsigned char* buf, int rb, int h, int q, int lane) {
    asm volatile("" : "+v"(lane));
    bf16_t* proj = (bf16_t*)(p.ws + WS_PROJ);
    LAS unsigned char* gt = buf + P3_G + q * 2048;
#pragma unroll
    for (int k = 0; k < 2; ++k) { const int r = 16 * k + (lane >> 2), pc = lane & 3;
        const u32x4 v = *(const LAS u32x4*)(gt + k * 1024 + lane * 16);
        *(u32x4*)(proj + ((unsigned)(rb + r) * (unsigned)LDP + (unsigned)(1024 + h * 128 + 32 * q + pc * 8))) = v; }
    LDS_WAIT();
}

DI void ssd_chunk(const Params& p, LAS unsigned char* buf, LAS unsigned char* dtl, f32x16 (&ST)[4], f2_t dc, int rb, int w, int hd, int ph, float Dh, int lane) {
    asm volatile("" : "+v"(lane));
    const int l = lane & 31, half = lane >> 5;
    float* SSQ = (float*)(p.ws + WS_SSQ);
    LAS unsigned char* bt = buf + P3_BT; LAS unsigned char* ct = buf + P3_CT; LAS unsigned char* btt = buf + P3_BTT;
    LAS unsigned char* xt = buf + P3_X + w * 2048; LAS unsigned char* zt = buf + P3_Z + w * 2048;
    const float acs = dc[1];
    if (half == 0) *(LAS f2_t*)(dtl + l * 8) = dc;
    LDS_WAIT();
    const float atot = *(const LAS float*)(dtl + 31 * 8 + 4);
    float acs_r[16];
    float xf[16];
    bf16x8 xdf[2], xef[2];
    {
#pragma unroll
      for (int reg = 0; reg < 16; ++reg) xf[reg] = bf2f(*(const LAS bf16_t*)(xt + crow(reg, half) * 64 + l * 2));
      float xd[16], xe[16];
#pragma unroll
      for (int reg = 0; reg < 16; ++reg) { const f2_t dr = *(const LAS f2_t*)(dtl + crow(reg, half) * 8); acs_r[reg] = dr[1];
          xd[reg] = xf[reg] * dr[0]; xe[reg] = xd[reg] * __builtin_amdgcn_exp2f(atot - acs_r[reg]); }
#pragma unroll
      for (int ks = 0; ks < 2; ++ks) { xdf[ks] = pack8(xd[8 * ks], xd[8 * ks + 1], xd[8 * ks + 2], xd[8 * ks + 3], xd[8 * ks + 4], xd[8 * ks + 5], xd[8 * ks + 6], xd[8 * ks + 7]);
          xef[ks] = pack8(xe[8 * ks], xe[8 * ks + 1], xe[8 * ks + 2], xe[8 * ks + 3], xe[8 * ks + 4], xe[8 * ks + 5], xe[8 * ks + 6], xe[8 * ks + 7]); } }
    f32x16 yo, cbt;
#pragma unroll
    for (int i = 0; i < 16; ++i) { yo[i] = 0.f; cbt[i] = 0.f; }
#pragma unroll
    for (int nb = 0; nb < 4; ++nb)
#pragma unroll
        for (int sp = 0; sp < 2; ++sp) { const int f = 2 * nb + sp; const int so = l * 256 + (((2 * f + half) ^ (l & 15)) * 16);
            const bf16x8 Cf = *(const LAS bf16x8*)(ct + so), Bf = *(const LAS bf16x8*)(bt + so);
            const bf16x8 Sf = pack8(ST[nb][8 * sp], ST[nb][8 * sp + 1], ST[nb][8 * sp + 2], ST[nb][8 * sp + 3], ST[nb][8 * sp + 4], ST[nb][8 * sp + 5], ST[nb][8 * sp + 6], ST[nb][8 * sp + 7]);
            yo = MFMA32(Cf, Sf, yo); cbt = MFMA32(Bf, Cf, cbt); }
    f32x16 yd;
    { float Gv[16];
#pragma unroll
      for (int reg = 0; reg < 16; ++reg) { const int s = crow(reg, half); const float e = __builtin_amdgcn_exp2f(acs - acs_r[reg]); Gv[reg] = (l >= s) ? cbt[reg] * e : 0.f; }
#pragma unroll
      for (int i = 0; i < 16; ++i) yd[i] = 0.f;
#pragma unroll
      for (int ks = 0; ks < 2; ++ks) { const bf16x8 Gf = pack8(Gv[8 * ks], Gv[8 * ks + 1], Gv[8 * ks + 2], Gv[8 * ks + 3], Gv[8 * ks + 4], Gv[8 * ks + 5], Gv[8 * ks + 6], Gv[8 * ks + 7]);
          yd = MFMA32(Gf, xdf[ks], yd); } }
    { const float eat = __builtin_amdgcn_exp2f(atot);
#pragma unroll
      for (int nb = 0; nb < 4; ++nb) { f32x16 a = ST[nb] * eat; const int n = 32 * nb + l;
#pragma unroll
        for (int ks = 0; ks < 2; ++ks) { const bf16x8 Bf = *(const LAS bf16x8*)(btt + n * 64 + (((2 * ks + half) ^ ((n >> 2) & 3)) * 16)); a = MFMA32(Bf, xef[ks], a); }
        ST[nb] = a; } }
#pragma unroll
    for (int reg = 0; reg < 16; ++reg) { const int t = crow(reg, half);
        const float y = yd[reg] + __builtin_amdgcn_exp2f(acs_r[reg]) * yo[reg] + Dh * xf[reg];
        LAS bf16_t* zp = (LAS bf16_t*)(zt + t * 64 + l * 2);
        const float z = bf2f(*zp);
        *zp = f2bf(y * silu(z)); }
    LDS_WAIT();
    {
      const u32x4 a = *(const LAS u32x4*)(zt + l * 64 + half * 32), b = *(const LAS u32x4*)(zt + l * 64 + half * 32 + 16);
      float v[16];
      v[0] = bf_lo(a.x); v[1] = bf_hi(a.x); v[2] = bf_lo(a.y); v[3] = bf_hi(a.y); v[4] = bf_lo(a.z); v[5] = bf_hi(a.z); v[6] = bf_lo(a.w); v[7] = bf_hi(a.w);
      v[8] = bf_lo(b.x); v[9] = bf_hi(b.x); v[10] = bf_lo(b.y); v[11] = bf_hi(b.y); v[12] = bf_lo(b.z); v[13] = bf_hi(b.z); v[14] = bf_lo(b.w); v[15] = bf_hi(b.w);
      float ss = 0.f;
#pragma unroll
      for (int i = 0; i < 16; ++i) ss += v[i] * v[i];
      ss += __shfl_xor(ss, 32);
      if (half == 0) SSQ[(unsigned)(rb + l) * 32u + (unsigned)(hd * 2 + ph)] = ss; }
}
DI void ssd_flush(const Params& p, LAS unsigned char* buf, int rb, int w, int hd, int ph, int lane) {
    asm volatile("" : "+v"(lane));
    bf16_t* proj = (bf16_t*)(p.ws + WS_PROJ);
    LAS unsigned char* zt = buf + P3_Z + w * 2048;
#pragma unroll
    for (int k = 0; k < 2; ++k) { const int r = 16 * k + (lane >> 2), pc = lane & 3;
        const u32x4 v = *(const LAS u32x4*)(zt + k * 1024 + lane * 16);
        *(u32x4*)(proj + ((unsigned)(rb + r) * (unsigned)LDP + (unsigned)(2048 + hd * 64 + ph * 32 + pc * 8))) = v; }
    LDS_WAIT();
}

#define P3_SYNC() do { asm volatile("s_waitcnt vmcnt(0) lgkmcnt(0)" ::: "memory"); __builtin_amdgcn_s_barrier(); asm volatile("" ::: "memory"); } while (0)
DI void phase3(const Params& p, LAS unsigned char* lds, int wave_s) {
    int tid = tid_of(wave_s); asm volatile("" : "+v"(tid));
    const int lane = tid & 63, wave = __builtin_amdgcn_readfirstlane(tid >> 6);
    const int l = lane & 31, half = lane >> 5;
    for (int job = 0; job < 2; ++job) {
        const int nblk = job == 0 ? 128 : 256, nch = job == 0 ? 1 : 64;
        for (int bi = blockIdx.x; bi < nblk; bi += gridDim.x) {
            const int pr = ((bi >> 5) << 3) | (bi & 7), b = pr >> 1, g = pr & 1, h = g * 4 + ((bi >> 3) & 3), hd0 = 2 * h;
            const int rowbase = job == 0 ? TP + b * 32 : b * 2048;
            if (wave < 4) {
                const int q = wave;
                const int pos0 = job == 0 ? 1024 : 0;
                const int ch = h * 128 + q * 32 + l;
                f32x16 st[4];
                P3_SYNC();
                p3_stage(p, lds, wave, lane, rowbase, rowbase >> 5, h, g, hd0);
                LAS bf16x8* wl = (LAS bf16x8*)(lds + 65536 + wave * 16384);
                { const float* Wa = p.in[14] + (size_t)h * 16384; const float* Wx = p.in[16] + (size_t)h * 16384;
                  const unsigned wo = (unsigned)(half * 1024 + q * 32 + l);
#pragma unroll 4
                  for (int s = 0; s < 8; ++s) { const unsigned o = wo + (unsigned)s * 2048u;
                      wl[s * 64 + lane] = pack8(Wa[o], Wa[o + 128u], Wa[o + 256u], Wa[o + 384u], Wa[o + 512u], Wa[o + 640u], Wa[o + 768u], Wa[o + 896u]);
                      wl[512 + s * 64 + lane] = pack8(Wx[o], Wx[o + 128u], Wx[o + 256u], Wx[o + 384u], Wx[o + 512u], Wx[o + 640u], Wx[o + 768u], Wx[o + 896u]); }
                  LDS_WAIT(); }
#pragma unroll
                for (int k = 0; k < 4; ++k)
#pragma unroll
                    for (int e = 0; e < 4; ++e) { const f32x4 t = __builtin_bit_cast(f32x4, wl[(k >> 1) * 512 + ((k & 1) * 4 + e) * 64 + lane]);
                        st[k][4 * e] = t[0]; st[k][4 * e + 1] = t[1]; st[k][4 * e + 2] = t[2]; st[k][4 * e + 3] = t[3]; }
                const float ba = -1.4426950408889634f * p.in[15][ch], bx = -1.4426950408889634f * p.in[17][ch], c8 = -8.f * 1.4426950408889634f * softplus(-p.in[18][ch]);
                float hc = job == 0 ? p.in[5][(size_t)b * 1024 + ch] : 0.f;
                P3_SYNC();
                for (int c = 0; c < nch; ++c) {
                    const int rb = rowbase + 32 * c;
                    if (c > 0) lru_flush(p, lds + ((c - 1) & 1) * P3_BUF, rb - 32, h, q, lane);
                    if (c + 1 < nch) p3_stage(p, lds + ((c + 1) & 1) * P3_BUF, wave, lane, rb + 32, (rb + 32) >> 5, h, g, hd0);
                    lru_chunk(p, lds + (c & 1) * P3_BUF, st, hc, pos0 + 32 * c, q, ba, bx, c8, lane);
                    P3_SYNC();
                }
                lru_flush(p, lds + ((nch - 1) & 1) * P3_BUF, rowbase + 32 * (nch - 1), h, q, lane);
                if (half == 0) p.out[(job == 0 ? O_LHS : O_LHP) + (size_t)b * 1024 + ch] = hc;
            } else {
                const int w = wave - 4, hd = hd0 + (w >> 1), ph = w & 1;
                const f2_t* DTC = (const f2_t*)(p.ws + WS_DTC);
                const float Dh = p.in[23][hd];
                LAS unsigned char* dtl = lds + 2 * P3_BUF + w * 256;
                P3_SYNC();
                p3_stage(p, lds, wave, lane, rowbase, rowbase >> 5, h, g, hd0);
                f32x16 st[4];
                const float* sin = p.in[7] + ((size_t)b * 16 + hd) * 8192;
#pragma unroll
                for (int nb = 0; nb < 4; ++nb)
#pragma unroll
                    for (int r4 = 0; r4 < 4; ++r4) { f32x4 v = {0.f, 0.f, 0.f, 0.f};
                        if (job == 0) v = *(const f32x4*)(sin + (size_t)(ph * 32 + l) * 128 + 32 * nb + 8 * r4 + 4 * half);
                        st[nb][4 * r4 + 0] = v[0]; st[nb][4 * r4 + 1] = v[1]; st[nb][4 * r4 + 2] = v[2]; st[nb][4 * r4 + 3] = v[3]; }
                f2_t dtn = DTC[((unsigned)(rowbase >> 5) * 16u + (unsigned)hd) * 32u + (unsigned)l];
                P3_SYNC();
                for (int c = 0; c < nch; ++c) {
                    const int rb = rowbase + 32 * c;
                    if (c > 0) ssd_flush(p, lds + ((c - 1) & 1) * P3_BUF, rb - 32, w, hd, ph, lane);
                    if (c + 1 < nch) p3_stage(p, lds + ((c + 1) & 1) * P3_BUF, wave, lane, rb + 32, (rb + 32) >> 5, h, g, hd0);
                    const f2_t dtc = dtn;
                    if (c + 1 < nch) dtn = DTC[((unsigned)((rb + 32) >> 5) * 16u + (unsigned)hd) * 32u + (unsigned)l];
                    ssd_chunk(p, lds + (c & 1) * P3_BUF, dtl, st, dtc, rb, w, hd, ph, Dh, lane);
                    P3_SYNC();
                }
                ssd_flush(p, lds + ((nch - 1) & 1) * P3_BUF, rowbase + 32 * (nch - 1), w, hd, ph, lane);
                float* sout = p.out + (job == 0 ? O_SSS : O_SSP) + ((size_t)b * 16 + hd) * 8192;
#pragma unroll
                for (int nb = 0; nb < 4; ++nb)
#pragma unroll
                    for (int r4 = 0; r4 < 4; ++r4) { f32x4 v; v[0] = st[nb][4 * r4]; v[1] = st[nb][4 * r4 + 1]; v[2] = st[nb][4 * r4 + 2]; v[3] = st[nb][4 * r4 + 3];
                        *(f32x4*)(sout + (size_t)(ph * 32 + l) * 128 + 32 * nb + 8 * r4 + 4 * half) = v; }
            }
        }
    }
}

DI void phase5(const Params& p, int r4lo, int r4hi, int blk, int nblk, int wave_s) {
    int tid = tid_of(wave_s); asm volatile("" : "+v"(tid));
    const int lane = tid & 63, wave = __builtin_amdgcn_readfirstlane(tid >> 6);
    const int gw = blk * 8 + wave, NGW = nblk * 8;
    const bf16_t* op = (const bf16_t*)(p.ws + WS_R1);
    const float* psq = (const float*)(p.ws + WS_PSQ);
    f32x4 fg[4];
#pragma unroll
    for (int j = 0; j < 4; ++j) fg[j] = *(const f32x4*)(p.in[26] + 4 * lane + 256 * j);
    for (int r4 = r4lo + gw; r4 < r4hi; r4 += NGW) {
        const size_t row = (size_t)r4 * 4;
        u32x2 a[4][4]; f32x4 q[4][4];
#pragma unroll
        for (int i = 0; i < 4; ++i)
#pragma unroll
            for (int j = 0; j < 4; ++j) { a[i][j] = *(const u32x2*)(op + (row + i) * 1024 + 4 * lane + 256 * j); q[i][j] = *(const f32x4*)(psq + (row + i) * 16 + 4 * j); }
#pragma unroll
        for (int i = 0; i < 4; ++i) { const f32x4 s4 = (q[i][0] + q[i][1]) + (q[i][2] + q[i][3]);
            const float rstd = rsqrtf(((s4[0] + s4[1]) + (s4[2] + s4[3])) * (1.f / 1024.f) + EPS);
            float* o = p.out + (row + i) * 1024 + 4 * lane;
#pragma unroll
            for (int j = 0; j < 4; ++j) { f32x4 v; v[0] = bf_lo(a[i][j].x); v[1] = bf_hi(a[i][j].x); v[2] = bf_lo(a[i][j].y); v[3] = bf_hi(a[i][j].y);
                *(f32x4*)(o + 256 * j) = v * rstd * fg[j]; } }
    }
}

DI void grid_bar(unsigned* ctr, unsigned nb, int wave_s) {
    asm volatile("s_waitcnt vmcnt(0) lgkmcnt(0)" ::: "memory");
    __syncthreads();
    if (tid_of(wave_s) == 0) {
        const unsigned grp = blockIdx.x & 31u, gsz = (gridDim.x - grp + 31u) >> 5, ngrp = gridDim.x < 32u ? gridDim.x : 32u;
        __builtin_amdgcn_fence(__ATOMIC_RELEASE, "agent");
        asm volatile("s_waitcnt vmcnt(0)" ::: "memory");
        const unsigned old = __hip_atomic_fetch_add(ctr + 32u * grp, 1u, __ATOMIC_RELAXED, __HIP_MEMORY_SCOPE_AGENT);
        if (old + 1u == nb * gsz) __hip_atomic_fetch_add(ctr + 32u * 32u, 1u, __ATOMIC_RELAXED, __HIP_MEMORY_SCOPE_AGENT);
        while (__hip_atomic_load(ctr + 32u * 32u, __ATOMIC_RELAXED, __HIP_MEMORY_SCOPE_AGENT) < nb * ngrp) __builtin_amdgcn_s_sleep(4);
        __builtin_amdgcn_fence(__ATOMIC_ACQUIRE, "agent");
        asm volatile("s_waitcnt vmcnt(0)" ::: "memory");
    }
    __syncthreads();
}

constexpr int NPHASE = 7;
template <bool COOP>
__global__ __launch_bounds__(512, 2) void fwd_k(Params p, int ph_lo, int ph_hi) {
    extern __shared__ __attribute__((aligned(16))) unsigned char shm[];
    LAS unsigned char* lds = (LAS unsigned char*)shm;
    const int wave_s = __builtin_amdgcn_readfirstlane((int)threadIdx.x >> 6);
#define RUN(k) (ph_lo <= (k) && (k) < ph_hi && ((PHASE_MASK >> (k)) & 1))
    unsigned* bar_ctr = (unsigned*)(p.ws + WS_CTR);
    if (COOP && ph_hi > 1000) cg::this_grid().sync();
    unsigned nbar = 0;
#define SEAM(k) do { if (COOP && ph_lo <= (k) && (k) + 1 < ph_hi) grid_bar(bar_ctr, ++nbar, wave_s); } while (0)
#define NREP(k) ((((REP_MASK & ~4) >> (k)) & 1) ? 2 : 1)
    for (int rep = 0; rep < NREP(0); ++rep) { if (RUN(0)) phase0(p, lds, wave_s); if (rep + 1 < NREP(0)) cg::this_grid().sync(); }
    SEAM(0);
    for (int rep = 0; rep < NREP(1); ++rep) { if (RUN(1)) phase1(p, lds, wave_s); if (rep + 1 < NREP(1)) cg::this_grid().sync(); }
    SEAM(1);
    for (int rep = 0; rep < NREP(2); ++rep) { if (rep) cg::this_grid().sync(); if (RUN(2)) {
        g8::Gemm g; g.A = (const bf16_t*)(p.ws + WS_R1); g.Bt = (const bf16_t*)(p.ws + WS_WIN); g.lda = 1024; g.ldb = 1024;
        g8::SchedIn S; S.nM = MT / 256; S.nN = LDP / 256; S.G = (int)gridDim.x; S.c = (int)blockIdx.x;
        g8::EpiProj E; E.O = (bf16_t*)(p.ws + WS_PROJ); E.dt = (float*)(p.ws + WS_DT);
        { const int nun = (MT / 256) * (LDP / 256), extra = nun % (int)gridDim.x;
          if (extra > 0 && (int)blockIdx.x >= extra) { const int d = ((int)blockIdx.x - extra) & 7; for (int i = 0; i < d; ++i) __builtin_amdgcn_s_sleep(100); } }
        g8::gemm_phase<g8::EpiProj, g8::SchedIn>(lds, g, S, E, wave_s);
    } }
    SEAM(2);
    for (int rep = 0; rep < NREP(3); ++rep) { if (RUN(3)) phase2b(p, lds, wave_s); if (rep + 1 < NREP(3)) cg::this_grid().sync(); }
    SEAM(3);
    if (RUN(4)) phase3(p, lds, wave_s);
    SEAM(4);
    if (RUN(5)) {
        for (int pass = 0; pass < 2; ++pass) {
            if (pass == 1 && COOP) grid_bar(bar_ctr, ++nbar, wave_s);
            const bool gemm_blk = (pass == 0) || (blockIdx.x < 8 && gridDim.x > 8);
            if (gemm_blk) {
                g8::Gemm g; g.A = (const bf16_t*)(p.ws + WS_PROJ); g.Bt = (const bf16_t*)(p.ws + WS_WOUT); g.lda = LDP; g.ldb = 2048;
                g8::SchedOut S; S.nN = 4; S.c = (int)blockIdx.x;
                S.nM = pass == 0 ? TP / 256 : TS / 256; S.G = pass == 0 ? (int)gridDim.x : 8; S.pm0 = pass == 0 ? 0 : TP / 256;
                g8::EpiOut E; E.ssq = (const float*)(p.ws + WS_SSQ); E.xp = p.in[0]; E.xs = p.in[1]; E.mod = (const float*)(p.ws + WS_MOD);
                E.outp = (bf16_t*)(p.ws + WS_R1); E.psq = (float*)(p.ws + WS_PSQ); E.dummy = 0; E.fl = lds + 131072;
                g8::gemm_phase<g8::EpiOut, g8::SchedOut>(lds, g, S, E, wave_s);
            } else phase5(p, 0, TP / 4, (int)blockIdx.x - 8, (int)gridDim.x - 8, wave_s);
        }
        if (COOP) grid_bar(bar_ctr, ++nbar, wave_s);
        phase5(p, TP / 4, MT / 4, (int)blockIdx.x, (int)gridDim.x, wave_s);
    }
#undef RUN
#undef SEAM
}

extern "C" void kernel_launch(void* const* d_in, const int* in_sizes, int n_in, void* d_out, int out_size, void* d_ws, size_t ws_size, hipStream_t stream) {
    static int grid = 0;
    if (grid == 0) {
        if (n_in != 27 || ws_size < WS_END) { fprintf(stderr, "kernel_launch: unexpected n_in %d or ws_size %zu (< %zu)\n", n_in, ws_size, (size_t)WS_END); grid = -1; return; }
        int dev = 0, cus = 0, per_cu = 0;
        (void)hipGetDevice(&dev);
        (void)hipDeviceGetAttribute(&cus, hipDeviceAttributeMultiprocessorCount, dev);
        (void)hipFuncSetAttribute((const void*)fwd_k<ONE_LAUNCH != 0>, hipFuncAttributeMaxDynamicSharedMemorySize, LDS_BYTES);
        (void)hipOccupancyMaxActiveBlocksPerMultiprocessor(&per_cu, (const void*)fwd_k<ONE_LAUNCH != 0>, 512, LDS_BYTES);
        if (per_cu < 1) fprintf(stderr, "kernel_launch: occupancy query reports %d blocks per CU\n", per_cu);
        (void)hipGetLastError();
        grid = cus > 0 ? cus : 256;
    }
    if (grid < 0) return;
    Params p{};
    for (int i = 0; i < 27; ++i) p.in[i] = (const float*)d_in[i];
    p.out = (float*)d_out; p.ws = (unsigned char*)d_ws;
#if ONE_LAUNCH
    (void)hipMemsetAsync((unsigned char*)d_ws + WS_CTR, 0, 8192, stream);
    int lo = 0, hi = NPHASE;
    void* args[] = {&p, &lo, &hi};
    hipError_t e = hipLaunchCooperativeKernel((const void*)fwd_k<true>, dim3(grid), dim3(512), args, LDS_BYTES, stream);
    if (e != hipSuccess) fprintf(stderr, "cooperative launch failed: %s (grid %d)\n", hipGetErrorString(e), grid);
#else
    for (int ph = 0; ph < NPHASE; ++ph) hipLaunchKernelGGL(fwd_k<false>, dim3(grid), dim3(512), LDS_BYTES, stream, p, ph, ph + 1);
#endif
}
```

```cpp
#include <hip/hip_runtime.h>
#include <hip/hip_cooperative_groups.h>
#include <cstdio>
namespace cg = cooperative_groups;

#ifndef PHASE_MASK
#define PHASE_MASK 0x7f
#endif
#ifndef REP_MASK
#define REP_MASK 0
#endif
#ifndef PROBE_P4
#define PROBE_P4 0
#endif
#ifndef ONE_LAUNCH
#define ONE_LAUNCH 1
#endif

#define LAS __attribute__((address_space(3)))
#define DI __device__ __forceinline__
typedef unsigned short bf16_t;
typedef short bf16x8 __attribute__((ext_vector_type(8)));
typedef float f32x4 __attribute__((ext_vector_type(4)));
typedef float f32x16 __attribute__((ext_vector_type(16)));
typedef unsigned u32x4 __attribute__((ext_vector_type(4)));
typedef unsigned u32x2 __attribute__((ext_vector_type(2)));
typedef __bf16 bf2_t __attribute__((ext_vector_type(2)));
typedef float f2_t __attribute__((ext_vector_type(2)));

constexpr int TP = 65536, TS = 512, MT = TP + TS;
constexpr int LDP = 4608;
constexpr int NPAD = 4864;
constexpr float EPS = 1e-6f;
constexpr size_t O_YP = 0, O_YS = 67108864, O_LCP = O_YS + 524288, O_LHP = O_LCP + 98304, O_SCP = O_LHP + 32768, O_SSP = O_SCP + 147456,
                 O_LCS = O_SSP + 4194304, O_LHS = O_LCS + 49152, O_SCS = O_LHS + 16384, O_SSS = O_SCS + 73728;
constexpr size_t WS_MOD = 0;
constexpr size_t WS_R1 = 1048576;
constexpr size_t WS_WIN = WS_R1 + (size_t)MT * 1024 * 2;
constexpr size_t WS_WOUT = WS_WIN + (size_t)NPAD * 1024 * 2;
constexpr size_t WS_PROJ = WS_WOUT + (size_t)1024 * 2048 * 2;
constexpr size_t WS_DT = WS_PROJ + (size_t)MT * LDP * 2;
constexpr size_t WS_BC = WS_DT + (size_t)MT * 16 * 4;
constexpr size_t WS_BT = WS_BC + (size_t)MT * 512 * 2;
constexpr size_t WS_XT = WS_BT + (size_t)MT * 256 * 2;
constexpr size_t WS_SSQ = WS_XT + (size_t)MT * 1024 * 2;
constexpr size_t WS_PSQ = WS_SSQ + (size_t)MT * 32 * 4;
constexpr size_t WS_CTR = WS_PSQ + (size_t)MT * 16 * 4;
constexpr size_t WS_RS = WS_CTR + 8192;
constexpr size_t WS_DTC = WS_RS + (size_t)MT * 2 * 4;
constexpr size_t WS_WDT = WS_DTC + (size_t)MT * 16 * 2 * 4;
constexpr size_t WS_END = WS_WDT + 16 * 1024 * 2;
constexpr int LDS_BYTES = 131072 + 2048;

struct Params { const float* in[27]; float* out; unsigned char* ws; };

DI unsigned pk2(float a, float b) { f2_t v = {a, b}; return __builtin_bit_cast(unsigned, __builtin_convertvector(v, bf2_t)); }
DI bf16_t f2bf(float a) { return (bf16_t)(pk2(a, 0.f) & 0xffffu); }
DI float bf_lo(unsigned u) { return __uint_as_float(u << 16); }
DI float bf_hi(unsigned u) { return __uint_as_float(u & 0xffff0000u); }
DI float bf2f(bf16_t h) { return __uint_as_float(((unsigned)h) << 16); }
DI float fexp(float x) { return __builtin_amdgcn_exp2f(x * 1.4426950408889634f); }
DI float sigm(float x) { return __builtin_amdgcn_rcpf(1.f + fexp(-x)); }
DI float silu(float x) { return x * __builtin_amdgcn_rcpf(1.f + fexp(-x)); }
DI float one_minus_exp(float x, float ex) { const float ser = -x * (1.f + x * (0.5f + x * (0.16666667f + x * (0.041666668f + x * 0.0083333338f)))); return x > -0.125f ? ser : 1.f - ex; }
DI float softplus(float x) { return x > 20.f ? x : log1pf(fexp(x)); }
DI int tid_of(int wave_s) { return (wave_s << 6) | (int)__builtin_amdgcn_mbcnt_hi(~0u, __builtin_amdgcn_mbcnt_lo(~0u, 0u)); }
DI int crow(int reg, int h) { return (reg & 3) + 8 * (reg >> 2) + 4 * h; }
#define MFMA32(a, b, c) __builtin_amdgcn_mfma_f32_32x32x16_bf16((a), (b), (c), 0, 0, 0)
#define LDS_WAIT() asm volatile("s_waitcnt lgkmcnt(0)" ::: "memory")

namespace g8 {
constexpr int BM = 256, BK = 64, HALF = 128, HTB = HALF * BK * 2, NXCD = 8, WGM = 8;
DI int lds_byte(int r, int c) { const int st = (r >> 4) * 2 + (c >> 5), rr = r & 15, cc = c & 31, ob = rr * 64 + cc * 2; return st * 1024 + (ob ^ (((ob >> 9) & 1) << 5)); }
DI void stage_rc(int b, int& R, int& C) { const int st = b / 1024, sb = b % 1024, swz = sb ^ (((sb >> 9) & 1) << 5); R = (st >> 1) * 16 + swz / 64; C = (st & 1) * 32 + (swz % 64) / 2; }
DI int perm32(int rho) { const int n = rho >> 4, i = rho & 15; return 8 * (i >> 2) + 4 * n + (i & 3); }
struct Unit { int pm, pn, seg; };
DI void tile_of(int wgid, int nM, int nN, int& pm, int& pn) {
    const int nwg = nM * nN, q = nwg / NXCD, r = nwg % NXCD, xcd = wgid % NXCD, off = wgid / NXCD;
    wgid = (xcd < r ? xcd * (q + 1) : r * (q + 1) + (xcd - r) * q) + off;
    const int nig = WGM * nN, gid = wgid / nig, fm = gid * WGM, gsz = (nM - fm) < WGM ? (nM - fm) : WGM;
    pm = fm + ((wgid % nig) % gsz); pn = (wgid % nig) / gsz;
}
struct Gemm { const bf16_t* A; const bf16_t* Bt; int lda, ldb; };

struct SchedIn {
    int nM, nN, G, c;
#if REP_MASK & 4
    DI bool next(int i, Unit& u) const { long L = (long)i * G + c; const long nwg = (long)nM * nN; if (L >= 2 * nwg) return false; if (L >= nwg) L -= nwg; tile_of((int)L, nM, nN, u.pm, u.pn); u.seg = 0; return true; }
#else
    DI bool next(int i, Unit& u) const { const long L = (long)i * G + c; if (L >= (long)nM * nN) return false; tile_of((int)L, nM, nN, u.pm, u.pn); u.seg = 0; return true; }
#endif
    DI int nt(const Unit&) const { return 16; }
    DI size_t aoff(const Unit& u) const { return (size_t)u.pm * 256 * 1024 * 2; }
    DI size_t boff(const Unit& u) const { return (size_t)u.pn * 256 * 1024 * 2; }
    DI bool fresh(const Unit&) const { return true; }
};
struct SchedOut {
    int nM, nN, G, c, pm0;
    DI bool next(int i, Unit& u) const { const int ti = i / 3; u.seg = i - 3 * ti; const long L = (long)ti * G + c; if (c >= G || L >= (long)nM * nN) return false; tile_of((int)L, nM, nN, u.pm, u.pn); u.pm += pm0; return true; }
    DI int nt(const Unit& u) const { return u.seg == 2 ? 16 : 8; }
    DI int kofs(const Unit& u) const { return u.seg == 0 ? 1024 : (u.seg == 1 ? 1536 : 0); }
    DI size_t aoff(const Unit& u) const { return ((size_t)u.pm * 256 * LDP + 1024 + kofs(u)) * 2; }
    DI size_t boff(const Unit& u) const { return ((size_t)u.pn * 256 * 2048 + kofs(u)) * 2; }
    DI bool fresh(const Unit& u) const { return u.seg == 0; }
};

template <class Epi, class Sched>
DI void gemm_phase(LAS unsigned char* lds, const Gemm g, const Sched& S, Epi& E, int wave_s) {
    int tid = tid_of(wave_s); asm volatile("" : "+v"(tid));
    const int wid = __builtin_amdgcn_readfirstlane(tid >> 6), lane = tid & 63, wr = wid >> 2, wc = wid & 3, fr = lane & 15, fq = lane >> 4;
    unsigned voffA[2], voffB[2];
#pragma unroll
    for (int i = 0; i < 2; ++i) { int R, C; stage_rc(tid * 16 + i * 8192, R, C); const int Rb = Epi::PERM ? ((R & ~31) + perm32(R & 31)) : R;
        voffA[i] = (unsigned)(R * g.lda + C) * 2u; voffB[i] = (unsigned)(Rb * g.ldb + C) * 2u; }
    const size_t kstep = (size_t)(BK * 2);
    const size_t hstepA = (size_t)HALF * g.lda * 2, hstepB = (size_t)HALF * g.ldb * 2;
    const unsigned ldsw = (unsigned)wid * 1024u;
    const int aoff = lds_byte(wr * 64 + fr, fq * 8), boff = lds_byte(wc * 32 + fr, fq * 8);
#define PG8_SA(b, h) (((b) * 2 + (h)) * HTB)
#define PG8_SB(b, h) ((4 + (b) * 2 + (h)) * HTB)
#define PG8_STAGE(bufoff, gbase, voff) do { _Pragma("unroll") for (int _i = 0; _i < 2; ++_i) \
        __builtin_amdgcn_global_load_lds((const unsigned*)((const char*)(gbase) + (voff)[_i]), (LAS unsigned*)(lds + (bufoff) + ldsw + _i * 8192), 16, 0, 0); } while (0)
#define PG8_LDA(dst, b, h) do { _Pragma("unroll") for (int m = 0; m < 4; ++m) _Pragma("unroll") for (int k = 0; k < 2; ++k) dst[m][k] = *(const LAS bf16x8*)(lds + PG8_SA(b, h) + aoff + m * 2048 + k * 1024); } while (0)
#define PG8_LDB(dst, b, h) do { _Pragma("unroll") for (int n = 0; n < 2; ++n) _Pragma("unroll") for (int k = 0; k < 2; ++k) dst[n][k] = *(const LAS bf16x8*)(lds + PG8_SB(b, h) + boff + n * 2048 + k * 1024); } while (0)
#define PG8_MMA(ai, bj, At, Bt) do { __builtin_amdgcn_s_setprio(1); _Pragma("unroll") for (int m = 0; m < 4; ++m) _Pragma("unroll") for (int n = 0; n < 2; ++n) _Pragma("unroll") for (int k = 0; k < 2; ++k) \
        acc[ai][bj][m][n] = __builtin_amdgcn_mfma_f32_16x16x32_bf16(Bt[n][k], At[m][k], acc[ai][bj][m][n], 0, 0, 0); __builtin_amdgcn_s_setprio(0); } while (0)
#define PG8_WAIT_V(n) asm volatile("s_waitcnt vmcnt(" #n ")" ::: "memory")
#define PG8_WAIT_L(n) asm volatile("s_waitcnt lgkmcnt(" #n ")" ::: "memory")
#define PG8_BAR __builtin_amdgcn_s_barrier()
#define PG8_SCHED __builtin_amdgcn_sched_barrier(0)
    Unit cur, nxt; int ui = 0;
    if (!S.next(0, cur)) return;
    f32x4 acc[2][2][4][2];
#pragma unroll
    for (int a = 0; a < 2; ++a)
#pragma unroll
        for (int b = 0; b < 2; ++b)
#pragma unroll
            for (int m = 0; m < 4; ++m)
#pragma unroll
                for (int n = 0; n < 2; ++n) acc[a][b][m][n] = (f32x4){0.f, 0.f, 0.f, 0.f};
    bf16x8 At[4][2], B0[2][2], B1[2][2];
    const char* cA = (const char*)g.A + S.aoff(cur); const char* cB = (const char*)g.Bt + S.boff(cur);
    E.begin(cur, wave_s);
    PG8_STAGE(PG8_SB(0, 0), cB, voffB); PG8_STAGE(PG8_SA(0, 0), cA, voffA); PG8_STAGE(PG8_SB(0, 1), cB + hstepB, voffB); PG8_STAGE(PG8_SA(0, 1), cA + hstepA, voffA);
    if (wr == 1) PG8_BAR;
    PG8_WAIT_V(4); PG8_BAR;
    PG8_STAGE(PG8_SB(1, 0), cB + kstep, voffB); PG8_STAGE(PG8_SA(1, 0), cA + kstep, voffA); PG8_STAGE(PG8_SB(1, 1), cB + hstepB + kstep, voffB);
    PG8_WAIT_V(6); PG8_BAR;
    for (;;) {
        const bool has_next = S.next(ui + 1, nxt);
        const int nt = S.nt(cur);
        const char* nA = has_next ? (const char*)g.A + S.aoff(nxt) : cA; const char* nB = has_next ? (const char*)g.Bt + S.boff(nxt) : cB;
        for (int t = 0; t < nt; t += 2) {
            const bool last = (t == nt - 2);
            const char* a1 = cA + (size_t)(t + 1) * kstep;
            const char* a2 = last ? nA : cA + (size_t)(t + 2) * kstep; const char* b2 = last ? nB : cB + (size_t)(t + 2) * kstep;
            const char* a3 = a2 + kstep; const char* b3 = b2 + kstep;
            PG8_LDB(B0, 0, 0); PG8_SCHED; PG8_LDA(At, 0, 0); PG8_STAGE(PG8_SA(1, 1), a1 + hstepA, voffA);
            PG8_WAIT_L(8); PG8_BAR; PG8_WAIT_L(0); PG8_MMA(0, 0, At, B0); PG8_BAR; PG8_SCHED;
            PG8_LDB(B1, 0, 1); PG8_STAGE(PG8_SB(0, 0), b2, voffB);
            PG8_BAR; PG8_WAIT_L(0); PG8_MMA(0, 1, At, B1); PG8_BAR;
            PG8_LDA(At, 0, 1); PG8_STAGE(PG8_SA(0, 0), a2, voffA);
            PG8_BAR; PG8_WAIT_L(0); PG8_MMA(1, 0, At, B0); PG8_BAR; PG8_SCHED;
            PG8_STAGE(PG8_SB(0, 1), b2 + hstepB, voffB);
            PG8_WAIT_V(6); PG8_BAR; PG8_MMA(1, 1, At, B1); PG8_BAR;
            PG8_LDB(B0, 1, 0); PG8_SCHED; PG8_LDA(At, 1, 0); PG8_STAGE(PG8_SA(0, 1), a2 + hstepA, voffA);
            PG8_WAIT_L(8); PG8_BAR; PG8_WAIT_L(0); PG8_MMA(0, 0, At, B0); PG8_BAR; PG8_SCHED;
            PG8_LDB(B1, 1, 1); PG8_STAGE(PG8_SB(1, 0), b3, voffB);
            PG8_BAR; PG8_WAIT_L(0); PG8_MMA(0, 1, At, B1); PG8_BAR;
            PG8_LDA(At, 1, 1); PG8_STAGE(PG8_SA(1, 0), a3, voffA);
            PG8_BAR; PG8_WAIT_L(0); PG8_MMA(1, 0, At, B0); PG8_BAR; PG8_SCHED;
            PG8_STAGE(PG8_SB(1, 1), b3 + hstepB, voffB);
            PG8_WAIT_V(6); PG8_BAR; PG8_MMA(1, 1, At, B1); PG8_BAR;
        }
        E(acc, cur, nxt, has_next, wave_s, wr, wc, fr, fq);
        if (!has_next) break;
        if (S.fresh(nxt)) {
#pragma unroll
            for (int a = 0; a < 2; ++a)
#pragma unroll
                for (int b = 0; b < 2; ++b)
#pragma unroll
                    for (int m = 0; m < 4; ++m)
#pragma unroll
                        for (int n = 0; n < 2; ++n) acc[a][b][m][n] = (f32x4){0.f, 0.f, 0.f, 0.f};
        }
        cur = nxt; cA = nA; cB = nB; ++ui;
    }
    PG8_WAIT_V(0);
    if (wr == 0) PG8_BAR;
    PG8_BAR;
#undef PG8_SA
#undef PG8_SB
#undef PG8_STAGE
#undef PG8_LDA
#undef PG8_LDB
#undef PG8_MMA
#undef PG8_WAIT_V
#undef PG8_WAIT_L
#undef PG8_BAR
#undef PG8_SCHED
}

struct EpiProj {
    static constexpr bool PERM = true;
    bf16_t* O; float* dt;
    DI void begin(const Unit&, int) {}
    DI void operator()(f32x4 (&acc)[2][2][4][2], const Unit& u, const Unit&, bool, int, int wr, int wc, int fr, int fq) const {
        const int row0 = u.pm * BM + wr * 64 + fr;
        if (u.pn == 18) {
            if (wc == 0 && fq < 2) {
#pragma unroll
                for (int ai = 0; ai < 2; ++ai)
#pragma unroll
                    for (int m = 0; m < 4; ++m) { float* rp = dt + (size_t)(row0 + ai * HALF + m * 16) * 16 + 8 * fq;
                        *(f32x4*)(rp) = acc[ai][0][m][0]; *(f32x4*)(rp + 4) = acc[ai][0][m][1]; }
            }
            return;
        }
        const int col0 = u.pn * BM + wc * 32 + 8 * fq;
#pragma unroll
        for (int ai = 0; ai < 2; ++ai)
#pragma unroll
            for (int m = 0; m < 4; ++m) { bf16_t* rowp = O + (size_t)(row0 + ai * HALF + m * 16) * LDP + col0;
#pragma unroll
                for (int bj = 0; bj < 2; ++bj) { const f32x4 v0 = acc[ai][bj][m][0], v1 = acc[ai][bj][m][1];
                    u32x4 w; w.x = pk2(v0[0], v0[1]); w.y = pk2(v0[2], v0[3]); w.z = pk2(v1[0], v1[1]); w.w = pk2(v1[2], v1[3]);
                    *(u32x4*)(rowp + bj * HALF) = w; } }
    }
};
struct EpiOut {
    static constexpr bool PERM = true;
    const float* ssq; const float* xp; const float* xs; const float* mod; bf16_t* outp; float* psq; int dummy;
    LAS unsigned char* fl;
    DI void load_sc(const Unit& u, int wave_s) {
        const int tid = tid_of(wave_s);
        if (tid < 256) {
            const f32x4* q = (const f32x4*)(ssq + (size_t)(u.pm * BM + tid) * 32);
            const f32x4 a = (q[0] + q[1]) + (q[2] + q[3]), b = (q[4] + q[5]) + (q[6] + q[7]);
            const float s0 = (a[0] + a[1]) + (a[2] + a[3]), s1 = (b[0] + b[1]) + (b[2] + b[3]);
            const float r0 = rsqrtf(s0 * (1.f / 512.f) + EPS), r1 = rsqrtf(s1 * (1.f / 512.f) + EPS);
            f2_t o; o[0] = r0 / r1; o[1] = r1; *(LAS f2_t*)(fl + tid * 8) = o; }
    }
    DI void begin(const Unit& u, int wave_s) { load_sc(u, wave_s); }
    DI void operator()(f32x4 (&acc)[2][2][4][2], const Unit& u, const Unit& nxt, bool has_next, int wave_s, int wr, int wc, int fr, int fq) {
        if (PROBE_P4 && dummy) return;
        const int row0 = u.pm * BM + wr * 64 + fr;
        if (u.seg < 2) {
#pragma unroll
            for (int ai = 0; ai < 2; ++ai)
#pragma unroll
                for (int m = 0; m < 4; ++m) { const f2_t fv = *(const LAS f2_t*)(fl + (wr * 64 + fr + ai * HALF + m * 16) * 8); const float f = u.seg == 0 ? fv[0] : fv[1];
#pragma unroll
                    for (int bj = 0; bj < 2; ++bj)
#pragma unroll
                        for (int n = 0; n < 2; ++n) acc[ai][bj][m][n] = acc[ai][bj][m][n] * f; }
            return;
        }
        if (has_next) load_sc(nxt, wave_s);
        const int col0 = u.pn * BM + wc * 32 + 8 * fq;
        if (u.pm < TP / 256) {
            const float* gate = mod + (size_t)(u.pm >> 3) * 3072 + 2048 + col0;
            const f32x4 g00 = *(const f32x4*)(gate), g01 = *(const f32x4*)(gate + 4), g10 = *(const f32x4*)(gate + HALF), g11 = *(const f32x4*)(gate + HALF + 4);
#pragma unroll
            for (int ai = 0; ai < 2; ++ai) {
                f32x4 xv[4][4];
#pragma unroll
                for (int m = 0; m < 4; ++m) { const float* xrow = xp + (size_t)(row0 + ai * HALF + m * 16) * 1024 + col0;
                    xv[m][0] = *(const f32x4*)(xrow); xv[m][1] = *(const f32x4*)(xrow + 4); xv[m][2] = *(const f32x4*)(xrow + HALF); xv[m][3] = *(const f32x4*)(xrow + HALF + 4); }
#pragma unroll
                for (int m = 0; m < 4; ++m) { const int row = row0 + ai * HALF + m * 16;
                    const f32x4 v0 = xv[m][0] + g00 * acc[ai][0][m][0], v1 = xv[m][1] + g01 * acc[ai][0][m][1], v2 = xv[m][2] + g10 * acc[ai][1][m][0], v3 = xv[m][3] + g11 * acc[ai][1][m][1];
                    float ss = (v0[0] * v0[0] + v0[1] * v0[1]) + (v0[2] * v0[2] + v0[3] * v0[3]) + (v1[0] * v1[0] + v1[1] * v1[1]) + (v1[2] * v1[2] + v1[3] * v1[3])
                             + (v2[0] * v2[0] + v2[1] * v2[1]) + (v2[2] * v2[2] + v2[3] * v2[3]) + (v3[0] * v3[0] + v3[1] * v3[1]) + (v3[2] * v3[2] + v3[3] * v3[3]);
                    u32x4 w; w.x = pk2(v0[0], v0[1]); w.y = pk2(v0[2], v0[3]); w.z = pk2(v1[0], v1[1]); w.w = pk2(v1[2], v1[3]);
                    *(u32x4*)(outp + (size_t)row * 1024 + col0) = w;
                    w.x = pk2(v2[0], v2[1]); w.y = pk2(v2[2], v2[3]); w.z = pk2(v3[0], v3[1]); w.w = pk2(v3[2], v3[3]);
                    *(u32x4*)(outp + (size_t)row * 1024 + col0 + HALF) = w;
                    ss += __shfl_xor(ss, 16); ss += __shfl_xor(ss, 32);
                    if (fq == 0) psq[(size_t)row * 16 + u.pn * 4 + wc] = ss; }
            }
            return;
        }
#pragma unroll
        for (int ai = 0; ai < 2; ++ai)
#pragma unroll
            for (int m = 0; m < 4; ++m) { const int row = row0 + ai * HALF + m * 16;
                const int bb = 32 + ((row - TP) >> 5);
                const float* xrow = xs + (size_t)(row - TP) * 1024;
                const float* gate = mod + (size_t)bb * 3072 + 2048;
                float ss = 0.f;
#pragma unroll
                for (int bj = 0; bj < 2; ++bj) { const int c = col0 + bj * HALF;
                    const f32x4 x0 = *(const f32x4*)(xrow + c), x1 = *(const f32x4*)(xrow + c + 4);
                    const f32x4 g0 = *(const f32x4*)(gate + c), g1 = *(const f32x4*)(gate + c + 4);
                    const f32x4 v0 = x0 + g0 * acc[ai][bj][m][0], v1 = x1 + g1 * acc[ai][bj][m][1];
                    ss += (v0[0] * v0[0] + v0[1] * v0[1]) + (v0[2] * v0[2] + v0[3] * v0[3]) + (v1[0] * v1[0] + v1[1] * v1[1]) + (v1[2] * v1[2] + v1[3] * v1[3]);
                    u32x4 w; w.x = pk2(v0[0], v0[1]); w.y = pk2(v0[2], v0[3]); w.z = pk2(v1[0], v1[1]); w.w = pk2(v1[2], v1[3]);
                    *(u32x4*)(outp + (size_t)row * 1024 + c) = w; }
                ss += __shfl_xor(ss, 16); ss += __shfl_xor(ss, 32);
                if (fq == 0) psq[(size_t)row * 16 + u.pn * 4 + wc] = ss; }
    }
};
}

DI void tr_item(const float* W, int N, bf16_t* WT, int ldt, LAS float* scr, int kb, int nb, int lane, const float* kscale, int kscale_from) {
    const int k0 = 64 * kb, n0 = 32 * nb;
#pragma unroll
    for (int i = 0; i < 32; ++i) { const int kk = 2 * i + (lane >> 5), n = n0 + (lane & 31);
        float v = (n < N) ? W[(size_t)(k0 + kk) * N + n] : 0.f;
        if (kscale && (k0 + kk) >= kscale_from) v *= kscale[k0 + kk - kscale_from];
        scr[kk * 33 + (lane & 31)] = v; }
    LDS_WAIT();
    const int c = lane & 7;
#pragma unroll
    for (int j = 0; j < 4; ++j) { const int n = (lane >> 3) + 8 * j; const LAS float* s = scr + (8 * c) * 33 + n;
        u32x4 o; o.x = pk2(s[0 * 33], s[1 * 33]); o.y = pk2(s[2 * 33], s[3 * 33]); o.z = pk2(s[4 * 33], s[5 * 33]); o.w = pk2(s[6 * 33], s[7 * 33]);
        *(u32x4*)(WT + (size_t)(n0 + n) * ldt + k0 + 8 * c) = o; }
    LDS_WAIT();
}
DI void phase0(const Params& p, LAS unsigned char* lds, int wave_s) {
    int tid = tid_of(wave_s); asm volatile("" : "+v"(tid));
    const int lane = tid & 63, wave = __builtin_amdgcn_readfirstlane(tid >> 6);
    float* mod = (float*)(p.ws + WS_MOD);
    { bf16_t* wdt = (bf16_t*)(p.ws + WS_WDT);
      for (int i = blockIdx.x * 512 + tid; i < 16384; i += gridDim.x * 512) { const int n = i & 15, k = i >> 4; wdt[n * 1024 + k] = f2bf(p.in[11][(size_t)k * 4624 + 4608 + n]); } }
    for (int it = blockIdx.x; it < 288; it += gridDim.x) {
        const int rg = it / 48, cb = it % 48;
        LAS float* sc = (LAS float*)lds;
        LAS float* part = (LAS float*)(lds + 32768);
        for (int i = tid; i < 8192; i += 512) { const int r = i >> 10, k = i & 1023, bb = 8 * rg + r;
            const float c = bb < 32 ? p.in[2][bb * 1024 + k] : p.in[3][(bb - 32) * 1024 + k]; sc[i] = silu(c); }
        __syncthreads();
        const float* W = p.in[9] + (size_t)(128 * wave) * 3072 + cb * 64 + lane;
        float a[8] = {0.f, 0.f, 0.f, 0.f, 0.f, 0.f, 0.f, 0.f};
#pragma unroll 4
        for (int k4 = 0; k4 < 32; ++k4) {
            const float w0 = W[(size_t)(4 * k4 + 0) * 3072], w1 = W[(size_t)(4 * k4 + 1) * 3072], w2 = W[(size_t)(4 * k4 + 2) * 3072], w3 = W[(size_t)(4 * k4 + 3) * 3072];
#pragma unroll
            for (int r = 0; r < 8; ++r) { const f32x4 s4 = *(const LAS f32x4*)(sc + r * 1024 + 128 * wave + 4 * k4); a[r] += (s4[0] * w0 + s4[1] * w1) + (s4[2] * w2 + s4[3] * w3); } }
#pragma unroll
        for (int r = 0; r < 8; ++r) part[(wave * 8 + r) * 64 + lane] = a[r];
        __syncthreads();
        { const int r = tid >> 6, c = tid & 63; float v = p.in[10][cb * 64 + c];
#pragma unroll
          for (int w = 0; w < 8; ++w) v += part[(w * 8 + r) * 64 + c];
          mod[(size_t)(8 * rg + r) * 3072 + cb * 64 + c] = v; }
        __syncthreads();
    }
}

DI float wave_sum(float v) {
#pragma unroll
    for (int o = 1; o < 64; o <<= 1) v += __shfl_xor(v, o);
    return v;
}
DI void norm_row(const float* xrow, bf16_t* orow, const f32x4 (&gs)[4], const f32x4 (&sh)[4], int lane, LAS unsigned char* arow) {
    f32x4 v[4]; float s = 0.f;
#pragma unroll
    for (int j = 0; j < 4; ++j) { v[j] = *(const f32x4*)(xrow + 4 * lane + 256 * j); s += (v[j][0] * v[j][0] + v[j][1] * v[j][1]) + (v[j][2] * v[j][2] + v[j][3] * v[j][3]); }
    const float rstd = rsqrtf(wave_sum(s) * (1.f / 1024.f) + EPS);
#pragma unroll
    for (int j = 0; j < 4; ++j) { const f32x4 o = v[j] * rstd * gs[j] + sh[j]; u32x2 w; w.x = pk2(o[0], o[1]); w.y = pk2(o[2], o[3]);
        *(u32x2*)(orow + 4 * lane + 256 * j) = w; *(LAS u32x2*)(arow + (4 * lane + 256 * j) * 2) = w; }
}
DI void phase1(const Params& p, LAS unsigned char* lds, int wave_s) {
    int tid = tid_of(wave_s); asm volatile("" : "+v"(tid));
    const int lane = tid & 63, wave = __builtin_amdgcn_readfirstlane(tid >> 6);
    const int gw = blockIdx.x * 8 + wave, NGW = gridDim.x * 8;
    const float* mod = (const float*)(p.ws + WS_MOD);
    bf16_t* hn = (bf16_t*)(p.ws + WS_R1);
    f32x4 g4[4];
#pragma unroll
    for (int j = 0; j < 4; ++j) g4[j] = *(const f32x4*)(p.in[8] + 4 * lane + 256 * j);
    LAS unsigned char* arow = lds + wave * 8448;
    LAS unsigned char* wdl = lds + 67584;
    float* DT = (float*)(p.ws + WS_DT);
    { const u32x4* src = (const u32x4*)(p.ws + WS_WDT);
      for (int i = tid; i < 2048; i += 512) *(LAS u32x4*)(wdl + (i >> 7) * 2064 + (i & 127) * 16) = src[i];
      __syncthreads(); }
#define DT_STEP(nrows, row) do { LDS_WAIT(); f32x4 dacc = {0.f, 0.f, 0.f, 0.f}; \
        _Pragma("unroll 8") for (int kk = 0; kk < 32; ++kk) { \
            const bf16x8 fa = *(const LAS bf16x8*)(arow + (lane & 3) * 2064 + (32 * kk + 8 * (lane >> 4)) * 2); \
            const bf16x8 fb = *(const LAS bf16x8*)(wdl + (lane & 15) * 2064 + (32 * kk + 8 * (lane >> 4)) * 2); \
            dacc = __builtin_amdgcn_mfma_f32_16x16x32_bf16(fa, fb, dacc, 0, 0, 0); } \
        if (lane < 16) { _Pragma("unroll") for (int i = 0; i < (nrows); ++i) DT[((row) + i) * 16 + lane] = dacc[i]; } \
        LDS_WAIT(); } while (0)
    for (int rw = gw; rw < 2048 + 512; rw += NGW) {
        const bool samp = rw >= 2048;
        const int bb = samp ? 32 + ((rw - 2048) >> 5) : (rw >> 6);
        const float* mb = mod + (size_t)bb * 3072;
        f32x4 gs[4], sh[4];
#pragma unroll
        for (int j = 0; j < 4; ++j) { const f32x4 scl = *(const f32x4*)(mb + 1024 + 4 * lane + 256 * j); gs[j] = g4[j] * (scl + 1.f); sh[j] = *(const f32x4*)(mb + 4 * lane + 256 * j); }
        if (samp) { const int r = rw - 2048; norm_row(p.in[1] + (size_t)r * 1024, hn + (size_t)(TP + r) * 1024, gs, sh, lane, arow); DT_STEP(1, (size_t)(TP + r)); }
        else for (int r = 0; r < 32; r += 4) { const size_t row = (size_t)rw * 32 + r;
            const float* xr = p.in[0] + row * 1024 + 4 * lane; bf16_t* orow = hn + row * 1024 + 4 * lane;
            f32x4 v[4][4]; float s[4];
#pragma unroll
            for (int i = 0; i < 4; ++i)
#pragma unroll
                for (int j = 0; j < 4; ++j) v[i][j] = *(const f32x4*)(xr + i * 1024 + 256 * j);
#pragma unroll
            for (int i = 0; i < 4; ++i) { s[i] = 0.f;
#pragma unroll
                for (int j = 0; j < 4; ++j) s[i] += (v[i][j][0] * v[i][j][0] + v[i][j][1] * v[i][j][1]) + (v[i][j][2] * v[i][j][2] + v[i][j][3] * v[i][j][3]); }
#pragma unroll
            for (int o = 1; o < 64; o <<= 1) {
#pragma unroll
                for (int i = 0; i < 4; ++i) s[i] += __shfl_xor(s[i], o); }
#pragma unroll
            for (int i = 0; i < 4; ++i) { const float rstd = rsqrtf(s[i] * (1.f / 1024.f) + EPS);
#pragma unroll
                for (int j = 0; j < 4; ++j) { const f32x4 o = v[i][j] * rstd * gs[j] + sh[j]; u32x2 w; w.x = pk2(o[0], o[1]); w.y = pk2(o[2], o[3]);
                    *(u32x2*)(orow + i * 1024 + 256 * j) = w; *(LAS u32x2*)(arow + i * 2064 + (4 * lane + 256 * j) * 2) = w; } }
            DT_STEP(4, row); }
    }
#undef DT_STEP
    __syncthreads();
    LAS float* scr = (LAS float*)(lds + wave * 8448);
    constexpr int I_IN = 16 * 144, I_OUT = 32 * 32;
    for (int it = gw; it < I_IN + I_OUT; it += NGW) {
        if (it < I_IN) tr_item(p.in[11], 4624, (bf16_t*)(p.ws + WS_WIN), 1024, scr, it / 144, it % 144, lane, nullptr, 0);
        else { const int r = it - I_IN; tr_item(p.in[25], 1024, (bf16_t*)(p.ws + WS_WOUT), 2048, scr, r / 32, r % 32, lane, p.in[24], 1024); }
    }
}

DI void unpack8(const u32x4 v, float (&o)[8]) { o[0] = bf_lo(v.x); o[1] = bf_hi(v.x); o[2] = bf_lo(v.y); o[3] = bf_hi(v.y); o[4] = bf_lo(v.z); o[5] = bf_hi(v.z); o[6] = bf_lo(v.w); o[7] = bf_hi(v.w); }
DI void conv_group(const Params& p, const u32x4 (&raw)[8], float (&h0)[8], float (&h1)[8], float (&h2)[8], const float (&w0)[8], const float (&w1)[8], const float (&w2)[8],
                   const float (&w3)[8], const float (&bias)[8], int row0, int t0, bool lru, int c0, int cx, LAS bf16_t* T) {
    bf16_t* U = (bf16_t*)(p.ws + WS_R1);
    bf16_t* BC = (bf16_t*)(p.ws + WS_BC);
    bf16_t* XC = (bf16_t*)(p.ws + WS_XT);
#pragma unroll
    for (int ti = 0; ti < 8; ++ti) {
        float cur[8], o[8];
        unpack8(raw[ti], cur);
#pragma unroll
        for (int i = 0; i < 8; ++i) { o[i] = bias[i] + w0[i] * h0[i] + w1[i] * h1[i] + w2[i] * h2[i] + w3[i] * cur[i]; h0[i] = h1[i]; h1[i] = h2[i]; h2[i] = cur[i]; }
        u32x4 w;
        if (lru) { w.x = pk2(o[0], o[1]); w.y = pk2(o[2], o[3]); w.z = pk2(o[4], o[5]); w.w = pk2(o[6], o[7]);
            *(u32x4*)(U + ((unsigned)(row0 + ti) * 1024u + (unsigned)c0)) = w; }
        else { w.x = pk2(silu(o[0]), silu(o[1])); w.y = pk2(silu(o[2]), silu(o[3])); w.z = pk2(silu(o[4]), silu(o[5])); w.w = pk2(silu(o[6]), silu(o[7]));
            if (cx < 1024) *(u32x4*)(XC + ((unsigned)(row0 + ti) * 1024u + (unsigned)cx)) = w;
            else { const int cg = cx - 1024, off = cg & 15;
                const unsigned d = (unsigned)(row0 + ti) * 512u + (unsigned)((cg & ~15) + (off >> 1));
                u32x2 lo, hi; lo.x = w.x; lo.y = w.y; hi.x = w.z; hi.y = w.w;
                *(u32x2*)(BC + d) = lo; *(u32x2*)(BC + (d + 8u)) = hi;
                if (cg < 256) *(LAS u32x4*)(T + (t0 + ti) * 256 + cg) = w; } }
    }
}
DI void phase2b(const Params& p, LAS unsigned char* lds, int wave_s) {
    int tid = tid_of(wave_s); asm volatile("" : "+v"(tid));
    const bf16_t* proj = (const bf16_t*)(p.ws + WS_PROJ);
    for (int job = 0; job < 2; ++job) {
        for (int bi = blockIdx.x; bi < (job == 0 ? 256 : 16); bi += gridDim.x) {
            const bool samp = job == 1;
            const int rbase = samp ? TP + bi * 32 : bi * 256;
            const int nch = samp ? 1 : 8;
            const bool first = samp || ((bi & 7) == 0);
            if (tid < 320) {
                const int c0 = tid * 8;
                const bool lru = c0 < 1024;
                const int cx = c0 - 1024;
                const int pcol = lru ? c0 : 2048 + cx;
                const float* cw = lru ? p.in[12] + c0 : p.in[19] + cx; const int cwld = lru ? 1024 : 1536;
                const float* cbp = lru ? p.in[13] + c0 : p.in[20] + cx;
                float w0[8], w1[8], w2[8], w3[8], bias[8];
                { f32x4 a, b;
                  a = *(const f32x4*)(cw); b = *(const f32x4*)(cw + 4);
#pragma unroll
                  for (int i = 0; i < 4; ++i) { w0[i] = a[i]; w0[4 + i] = b[i]; }
                  a = *(const f32x4*)(cw + cwld); b = *(const f32x4*)(cw + cwld + 4);
#pragma unroll
                  for (int i = 0; i < 4; ++i) { w1[i] = a[i]; w1[4 + i] = b[i]; }
                  a = *(const f32x4*)(cw + 2 * cwld); b = *(const f32x4*)(cw + 2 * cwld + 4);
#pragma unroll
                  for (int i = 0; i < 4; ++i) { w2[i] = a[i]; w2[4 + i] = b[i]; }
                  a = *(const f32x4*)(cw + 3 * cwld); b = *(const f32x4*)(cw + 3 * cwld + 4);
#pragma unroll
                  for (int i = 0; i < 4; ++i) { w3[i] = a[i]; w3[4 + i] = b[i]; }
                  a = *(const f32x4*)(cbp); b = *(const f32x4*)(cbp + 4);
#pragma unroll
                  for (int i = 0; i < 4; ++i) { bias[i] = a[i]; bias[4 + i] = b[i]; } }
                float h0[8], h1[8], h2[8];
                if (!first) { unpack8(*(const u32x4*)(proj + (size_t)(rbase - 3) * LDP + pcol), h0); unpack8(*(const u32x4*)(proj + (size_t)(rbase - 2) * LDP + pcol), h1);
                    unpack8(*(const u32x4*)(proj + (size_t)(rbase - 1) * LDP + pcol), h2); }
                else if (samp) { const float* st = lru ? p.in[4] + (size_t)bi * 3 * 1024 + c0 : p.in[6] + (size_t)bi * 3 * 1536 + cx;
#pragma unroll
                    for (int i = 0; i < 8; ++i) { h0[i] = st[i]; h1[i] = st[cwld + i]; h2[i] = st[2 * cwld + i]; } }
                else {
#pragma unroll
                    for (int i = 0; i < 8; ++i) { h0[i] = 0.f; h1[i] = 0.f; h2[i] = 0.f; } }
                u32x4 ra[8], rb[8];
                const unsigned so = (unsigned)rbase * (unsigned)LDP + (unsigned)pcol;
#define LD8(dst, r) do { _Pragma("unroll") for (int i = 0; i < 8; ++i) dst[i] = *(const u32x4*)(proj + (so + (unsigned)((r) + i) * (unsigned)LDP)); } while (0)
                LD8(ra, 0);
                for (int c = 0; c < nch; ++c) {
                    __syncthreads();
                    LAS bf16_t* T = (LAS bf16_t*)(lds + (c & 1) * 16384);
                    const int row0 = rbase + 32 * c;
                    LD8(rb, 32 * c + 8);
                    conv_group(p, ra, h0, h1, h2, w0, w1, w2, w3, bias, row0, 0, lru, c0, cx, T);
                    LD8(ra, 32 * c + 16);
                    conv_group(p, rb, h0, h1, h2, w0, w1, w2, w3, bias, row0 + 8, 8, lru, c0, cx, T);
                    LD8(rb, 32 * c + 24);
                    conv_group(p, ra, h0, h1, h2, w0, w1, w2, w3, bias, row0 + 16, 16, lru, c0, cx, T);
                    if (c + 1 < nch) LD8(ra, 32 * c + 32);
                    conv_group(p, rb, h0, h1, h2, w0, w1, w2, w3, bias, row0 + 24, 24, lru, c0, cx, T);
                }
#undef LD8
                __syncthreads();
            } else {
                const int ct = tid - 320;
                const int hw = ct >> 5, t = ct & 31;
                bf16_t* BT = (bf16_t*)(p.ws + WS_BT);
                for (int c = 0; c <= nch; ++c) {
                    __syncthreads();
                    if (c < nch) {
                        const int r0 = rbase + 32 * c, ci = r0 >> 5;
                        for (int hd = hw; hd < 16; hd += 6) {
                            const float dtv = softplus(((const float*)(p.ws + WS_DT))[(size_t)(r0 + t) * 16 + hd] + p.in[21][hd]);
                            float acs = dtv * (-expf(p.in[22][hd]));
#pragma unroll
                            for (int o = 1; o < 32; o <<= 1) { const float v = __shfl_up(acs, o, 32); if (t >= o) acs += v; }
                            f2_t o2; o2[0] = dtv; o2[1] = acs * 1.4426950408889634f;
                            *(f2_t*)((float*)(p.ws + WS_DTC) + (((size_t)ci * 16 + hd) * 32 + t) * 2) = o2; } }
                    if (c >= 1) {
                        const LAS bf16_t* T = (const LAS bf16_t*)(lds + ((c - 1) & 1) * 16384);
                        const int ci = (rbase + 32 * (c - 1)) >> 5;
                        for (int cxx = ct; cxx < 256; cxx += 192) {
                            unsigned wv[16];
#pragma unroll
                            for (int wd = 0; wd < 16; ++wd) { const int pos = 2 * wd, ks = pos >> 4, h = (pos >> 3) & 1, j = pos & 7, s = 16 * ks + 8 * (j >> 2) + 4 * h + (j & 3);
                                const unsigned lo = T[s * 256 + cxx], hi = T[(s + 1) * 256 + cxx]; wv[wd] = lo | (hi << 16); }
                            bf16_t* d = BT + ((size_t)ci * 256 + cxx) * 32;
#pragma unroll
                            for (int i = 0; i < 4; ++i) { u32x4 o; o.x = wv[4 * i]; o.y = wv[4 * i + 1]; o.z = wv[4 * i + 2]; o.w = wv[4 * i + 3]; *(u32x4*)(d + 8 * i) = o; } } }
                }
                if (samp || (bi & 7) == 7) {
                    const int b = samp ? bi : (bi >> 3);
                    const size_t rlast = (size_t)rbase + 32 * nch - 3;
                    for (int i = ct; i < 3 * 2560; i += 192) { const int hr = i / 2560, c = i % 2560; const size_t row = rlast + hr;
                        if (c < 1024) { const float v = bf2f(proj[row * LDP + c]); p.out[(samp ? O_LCS : O_LCP) + ((size_t)b * 3 + hr) * 1024 + c] = v; }
                        else { const int cx = c - 1024; const float v = bf2f(proj[row * LDP + 2048 + cx]); p.out[(samp ? O_SCS : O_SCP) + ((size_t)b * 3 + hr) * 1536 + cx] = v; } }
                }
            }
        }
    }
    __syncthreads();
}

DI bf16x8 pack8(float a0, float a1, float a2, float a3, float a4, float a5, float a6, float a7) {
    u32x4 w; w.x = pk2(a0, a1); w.y = pk2(a2, a3); w.z = pk2(a4, a5); w.w = pk2(a6, a7); return __builtin_bit_cast(bf16x8, w);
}
constexpr int P3_BT = 0, P3_CT = 8192, P3_BTT = 16384, P3_UT = 24576, P3_X = 32768, P3_Z = 40960, P3_G = 49152, P3_BUF = 57344;
DI void glds16(const void* g, LAS unsigned char* l) { __builtin_amdgcn_global_load_lds((const unsigned*)g, (LAS unsigned*)l, 16, 0, 0); }
DI bf16x8 frag_of(const f32x16& v, int k) { f32x4 t; t[0] = v[4 * k]; t[1] = v[4 * k + 1]; t[2] = v[4 * k + 2]; t[3] = v[4 * k + 3]; return __builtin_bit_cast(bf16x8, t); }

DI void p3_stage(const Params& p, LAS unsigned char* buf, int wave, int lane, int rb, int ci, int h, int g, int hd0) {
    asm volatile("" : "+v"(lane));
    const bf16_t* U = (const bf16_t*)(p.ws + WS_R1);
    const bf16_t* proj = (const bf16_t*)(p.ws + WS_PROJ);
    const bf16_t* BC = (const bf16_t*)(p.ws + WS_BC);
    const bf16_t* BT = (const bf16_t*)(p.ws + WS_BT);
    const bf16_t* XT = (const bf16_t*)(p.ws + WS_XT);
    if (wave < 4) {
        const int q = wave;
#pragma unroll
        for (int kk = 0; kk < 2; ++kk) { const int k = 2 * q + kk, r = 4 * k + (lane >> 4), pc = (lane & 15) ^ (r & 15);
            glds16(U + ((unsigned)(rb + r) * 1024u + (unsigned)(h * 128 + pc * 8)), buf + P3_UT + k * 1024); }
#pragma unroll
        for (int k = 0; k < 2; ++k) { const int r = 16 * k + (lane >> 2), pc = lane & 3;
            glds16(proj + ((unsigned)(rb + r) * (unsigned)LDP + (unsigned)(1024 + h * 128 + 32 * q + pc * 8)), buf + P3_G + q * 2048 + k * 1024); }
    } else {
        const int w = wave - 4, hd = hd0 + (w >> 1), ph = w & 1, pch0 = hd * 64 + ph * 32;
#pragma unroll
        for (int kk = 0; kk < 2; ++kk) { const int k = 2 * w + kk, r = 4 * k + (lane >> 4), pc = (lane & 15) ^ (r & 15);
            glds16(BC + ((unsigned)(rb + r) * 512u + (unsigned)(g * 128 + pc * 8)), buf + P3_BT + k * 1024);
            glds16(BC + ((unsigned)(rb + r) * 512u + (unsigned)(256 + g * 128 + pc * 8)), buf + P3_CT + k * 1024);
            const int n = 16 * k + (lane >> 2), pc3 = (lane & 3) ^ ((n >> 2) & 3);
            glds16(BT + (((unsigned)ci * 256u + (unsigned)(g * 128 + n)) * 32u + (unsigned)(pc3 * 8)), buf + P3_BTT + k * 1024); }
#pragma unroll
        for (int k = 0; k < 2; ++k) { const int r = 16 * k + (lane >> 2);
            glds16(XT + ((unsigned)(rb + r) * 1024u + (unsigned)(pch0 + (lane & 3) * 8)), buf + P3_X + w * 2048 + k * 1024);
            glds16(proj + ((unsigned)(rb + r) * (unsigned)LDP + (unsigned)(3584 + pch0 + (lane & 3) * 8)), buf + P3_Z + w * 2048 + k * 1024); }
    }
}

DI void lru_chunk(const Params& p, LAS unsigned char* buf, const f32x16 (&st)[4], float& hc, int posc, int q, float ba, float bx, float c8, int lane) {
    asm volatile("" : "+v"(lane));
    const int j = lane & 31, half = lane >> 5;
    LAS unsigned char* ut = buf + P3_UT;
    LAS unsigned char* gt = buf + P3_G + q * 2048;
    const int pj = 16 * ((j >> 2) & 1) + 4 * (j >> 3) + (j & 3);
    f32x16 aR, aI;
#pragma unroll
    for (int i = 0; i < 16; ++i) { aR[i] = 0.f; aI[i] = 0.f; }
#pragma unroll
    for (int s = 0; s < 8; ++s) { const bf16x8 ua = *(const LAS bf16x8*)(ut + pj * 256 + (((2 * s + half) ^ (pj & 15)) * 16));
        aR = MFMA32(ua, frag_of(st[s >> 2], s & 3), aR); aI = MFMA32(ua, frag_of(st[2 + (s >> 2)], s & 3), aI); }
    float av[16], bv[16];
#pragma unroll
    for (int reg = 0; reg < 16; ++reg) { const int t = 16 * half + reg;
        const float u = bf2f(*(const LAS bf16_t*)(ut + t * 256 + (((4 * q + (j >> 3)) ^ (t & 15)) * 16) + (j & 7) * 2));
        const float r = __builtin_amdgcn_rcpf(1.f + __builtin_amdgcn_exp2f(__builtin_fmaf(aR[reg], -1.4426950408889634f, ba)));
        const float ii = __builtin_amdgcn_rcpf(1.f + __builtin_amdgcn_exp2f(__builtin_fmaf(aI[reg], -1.4426950408889634f, bx)));
        const float a = __builtin_amdgcn_exp2f(c8 * r);
        float mult = __builtin_amdgcn_sqrtf(__builtin_fmaf(-a, a, 1.f));
        if (reg == 0) mult = (posc == 0 && half == 0) ? 1.f : mult;
        av[reg] = a; bv[reg] = mult * ii * u; }
#pragma unroll
    for (int r = 1; r < 16; ++r) { bv[r] = av[r] * bv[r - 1] + bv[r]; av[r] = av[r] * av[r - 1]; }
    const float ho0 = av[15] * hc + bv[15];
    const float sh0 = __shfl(ho0, j);
    const float hin = half ? sh0 : hc;
    const float ho1 = av[15] * hin + bv[15];
    hc = __shfl(ho1, j + 32);
#pragma unroll
    for (int reg = 0; reg < 16; ++reg) { const int t = 16 * half + reg;
        const float hv = av[reg] * hin + bv[reg];
        LAS bf16_t* gp = (LAS bf16_t*)(gt + t * 64 + j * 2);
        const float g = bf2f(*gp);
        *gp = f2bf(hv * silu(g)); }
}
DI void lru_flush(const Params& p, LAS unsigned char* buf, int rb, int h, int q, int lane) {
    asm volatile("" : "+v"(lane));
    bf16_t* proj = (bf16_t*)(p.ws + WS_PROJ);
    LAS unsigned char* gt = buf + P3_G + q * 2048;
#pragma unroll
    for (int k = 0; k < 2; ++k) { const int r = 16 * k + (lane >> 2), pc = lane & 3;
        const u32x4 v = *(const LAS u32x4*)(gt + k * 1024 + lane * 16);
        *(u32x4*)(proj + ((unsigned)(rb + r) * (unsigned)LDP + (unsigned)(1024 + h * 128 + 32 * q + pc * 8))) = v; }
    LDS_WAIT();
}

DI void ssd_chunk(const Params& p, LAS unsigned char* buf, LAS unsigned char* dtl, f32x16 (&ST)[4], f2_t dc, int rb, int w, int hd, int ph, float Dh, int lane) {
    asm volatile("" : "+v"(lane));
    const int l = lane & 31, half = lane >> 5;
    float* SSQ = (float*)(p.ws + WS_SSQ);
    LAS unsigned char* bt = buf + P3_BT; LAS unsigned char* ct = buf + P3_CT; LAS unsigned char* btt = buf + P3_BTT;
    LAS unsigned char* xt = buf + P3_X + w * 2048; LAS unsigned char* zt = buf + P3_Z + w * 2048;
    const float acs = dc[1];
    if (half == 0) *(LAS f2_t*)(dtl + l * 8) = dc;
    LDS_WAIT();
    const float atot = *(const LAS float*)(dtl + 31 * 8 + 4);
    float acs_r[16];
    float xf[16];
    bf16x8 xdf[2], xef[2];
    {
#pragma unroll
      for (int reg = 0; reg < 16; ++reg) xf[reg] = bf2f(*(const LAS bf16_t*)(xt + crow(reg, half) * 64 + l * 2));
      float xd[16], xe[16];
#pragma unroll
      for (int reg = 0; reg < 16; ++reg) { const f2_t dr = *(const LAS f2_t*)(dtl + crow(reg, half) * 8); acs_r[reg] = dr[1];
          xd[reg] = xf[reg] * dr[0]; xe[reg] = xd[reg] * __builtin_amdgcn_exp2f(atot - acs_r[reg]); }
#pragma unroll
      for (int ks = 0; ks < 2; ++ks) { xdf[ks] = pack8(xd[8 * ks], xd[8 * ks + 1], xd[8 * ks + 2], xd[8 * ks + 3], xd[8 * ks + 4], xd[8 * ks + 5], xd[8 * ks + 6], xd[8 * ks + 7]);
          xef[ks] = pack8(xe[8 * ks], xe[8 * ks + 1], xe[8 * ks + 2], xe[8 * ks + 3], xe[8 * ks + 4], xe[8 * ks + 5], xe[8 * ks + 6], xe[8 * ks + 7]); } }
    f32x16 yo, cbt;
#pragma unroll
    for (int i = 0; i < 16; ++i) { yo[i] = 0.f; cbt[i] = 0.f; }
#pragma unroll
    for (int nb = 0; nb < 4; ++nb)
#pragma unroll
        for (int sp = 0; sp < 2; ++sp) { const int f = 2 * nb + sp; const int so = l * 256 + (((2 * f + half) ^ (l & 15)) * 16);
            const bf16x8 Cf = *(const LAS bf16x8*)(ct + so), Bf = *(const LAS bf16x8*)(bt + so);
            const bf16x8 Sf = pack8(ST[nb][8 * sp], ST[nb][8 * sp + 1], ST[nb][8 * sp + 2], ST[nb][8 * sp + 3], ST[nb][8 * sp + 4], ST[nb][8 * sp + 5], ST[nb][8 * sp + 6], ST[nb][8 * sp + 7]);
            yo = MFMA32(Cf, Sf, yo); cbt = MFMA32(Bf, Cf, cbt); }
    f32x16 yd;
    { float Gv[16];
#pragma unroll
      for (int reg = 0; reg < 16; ++reg) { const int s = crow(reg, half); const float e = __builtin_amdgcn_exp2f(acs - acs_r[reg]); Gv[reg] = (l >= s) ? cbt[reg] * e : 0.f; }
#pragma unroll
      for (int i = 0; i < 16; ++i) yd[i] = 0.f;
#pragma unroll
      for (int ks = 0; ks < 2; ++ks) { const bf16x8 Gf = pack8(Gv[8 * ks], Gv[8 * ks + 1], Gv[8 * ks + 2], Gv[8 * ks + 3], Gv[8 * ks + 4], Gv[8 * ks + 5], Gv[8 * ks + 6], Gv[8 * ks + 7]);
          yd = MFMA32(Gf, xdf[ks], yd); } }
    { const float eat = __builtin_amdgcn_exp2f(atot);
#pragma unroll
      for (int nb = 0; nb < 4; ++nb) { f32x16 a = ST[nb] * eat; const int n = 32 * nb + l;
#pragma unroll
        for (int ks = 0; ks < 2; ++ks) { const bf16x8 Bf = *(const LAS bf16x8*)(btt + n * 64 + (((2 * ks + half) ^ ((n >> 2) & 3)) * 16)); a = MFMA32(Bf, xef[ks], a); }
        ST[nb] = a; } }
#pragma unroll
    for (int reg = 0; reg < 16; ++reg) { const int t = crow(reg, half);
        const float y = yd[reg] + __builtin_amdgcn_exp2f(acs_r[reg]) * yo[reg] + Dh * xf[reg];
        LAS bf16_t* zp = (LAS bf16_t*)(zt + t * 64 + l * 2);
        const float z = bf2f(*zp);
        *zp = f2bf(y * silu(z)); }
    LDS_WAIT();
    {
      const u32x4 a = *(const LAS u32x4*)(zt + l * 64 + half * 32), b = *(const LAS u32x4*)(zt + l * 64 + half * 32 + 16);
      float v[16];
      v[0] = bf_lo(a.x); v[1] = bf_hi(a.x); v[2] = bf_lo(a.y); v[3] = bf_hi(a.y); v[4] = bf_lo(a.z); v[5] = bf_hi(a.z); v[6] = bf_lo(a.w); v[7] = bf_hi(a.w);
      v[8] = bf_lo(b.x); v[9] = bf_hi(b.x); v[10] = bf_lo(b.y); v[11] = bf_hi(b.y); v[12] = bf_lo(b.z); v[13] = bf_hi(b.z); v[14] = bf_lo(b.w); v[15] = bf_hi(b.w);
      float ss = 0.f;
#pragma unroll
      for (int i = 0; i < 16; ++i) ss += v[i] * v[i];
      ss += __shfl_xor(ss, 32);
      if (half == 0) SSQ[(unsigned)(rb + l) * 32u + (unsigned)(hd * 2 + ph)] = ss; }
}
DI void ssd_flush(const Params& p, LAS unsigned char* buf, int rb, int w, int hd, int ph, int lane) {
    asm volatile("" : "+v"(lane));
    bf16_t* proj = (bf16_t*)(p.ws + WS_PROJ);
    LAS unsigned char* zt = buf + P3_Z + w * 2048;
#pragma unroll
    for (int k = 0; k < 2; ++k) { const int r = 16 * k + (lane >> 2), pc = lane & 3;
        const u32x4 v = *(const LAS u32x4*)(zt + k * 1024 + lane * 16);
        *(u32x4*)(proj + ((unsigned)(rb + r) * (unsigned)LDP + (unsigned)(2048 + hd * 64 + ph * 32 + pc * 8))) = v; }
    LDS_WAIT();
}

#define P3_SYNC() do { asm volatile("s_waitcnt vmcnt(0) lgkmcnt(0)" ::: "memory"); __builtin_amdgcn_s_barrier(); asm volatile("" ::: "memory"); } while (0)
DI void phase3(const Params& p, LAS unsigned char* lds, int wave_s) {
    int tid = tid_of(wave_s); asm volatile("" : "+v"(tid));
    const int lane = tid & 63, wave = __builtin_amdgcn_readfirstlane(tid >> 6);
    const int l = lane & 31, half = lane >> 5;
    for (int job = 0; job < 2; ++job) {
        const int nblk = job == 0 ? 128 : 256, nch = job == 0 ? 1 : 64;
        for (int bi = blockIdx.x; bi < nblk; bi += gridDim.x) {
            const int pr = ((bi >> 5) << 3) | (bi & 7), b = pr >> 1, g = pr & 1, h = g * 4 + ((bi >> 3) & 3), hd0 = 2 * h;
            const int rowbase = job == 0 ? TP + b * 32 : b * 2048;
            if (wave < 4) {
                const int q = wave;
                const int pos0 = job == 0 ? 1024 : 0;
                const int ch = h * 128 + q * 32 + l;
                f32x16 st[4];
                LAS bf16x8* wl = (LAS bf16x8*)(lds + wave * 16384);
                { const float* Wa = p.in[14] + (size_t)h * 16384; const float* Wx = p.in[16] + (size_t)h * 16384;
                  const unsigned wo = (unsigned)(half * 1024 + q * 32 + l);
#pragma unroll 4
                  for (int s = 0; s < 8; ++s) { const unsigned o = wo + (unsigned)s * 2048u;
                      wl[s * 64 + lane] = pack8(Wa[o], Wa[o + 128u], Wa[o + 256u], Wa[o + 384u], Wa[o + 512u], Wa[o + 640u], Wa[o + 768u], Wa[o + 896u]);
                      wl[512 + s * 64 + lane] = pack8(Wx[o], Wx[o + 128u], Wx[o + 256u], Wx[o + 384u], Wx[o + 512u], Wx[o + 640u], Wx[o + 768u], Wx[o + 896u]); }
                  LDS_WAIT(); }
#pragma unroll
                for (int k = 0; k < 4; ++k)
#pragma unroll
                    for (int e = 0; e < 4; ++e) { const f32x4 t = __builtin_bit_cast(f32x4, wl[(k >> 1) * 512 + ((k & 1) * 4 + e) * 64 + lane]);
                        st[k][4 * e] = t[0]; st[k][4 * e + 1] = t[1]; st[k][4 * e + 2] = t[2]; st[k][4 * e + 3] = t[3]; }
                const float ba = -1.4426950408889634f * p.in[15][ch], bx = -1.4426950408889634f * p.in[17][ch], c8 = -8.f * 1.4426950408889634f * softplus(-p.in[18][ch]);
                float hc = job == 0 ? p.in[5][(size_t)b * 1024 + ch] : 0.f;
                P3_SYNC();
                p3_stage(p, lds, wave, lane, rowbase, rowbase >> 5, h, g, hd0);
                P3_SYNC();
                for (int c = 0; c < nch; ++c) {
                    const int rb = rowbase + 32 * c;
                    if (c > 0) lru_flush(p, lds + ((c - 1) & 1) * P3_BUF, rb - 32, h, q, lane);
                    if (c + 1 < nch) p3_stage(p, lds + ((c + 1) & 1) * P3_BUF, wave, lane, rb + 32, (rb + 32) >> 5, h, g, hd0);
                    lru_chunk(p, lds + (c & 1) * P3_BUF, st, hc, pos0 + 32 * c, q, ba, bx, c8, lane);
                    P3_SYNC();
                }
                lru_flush(p, lds + ((nch - 1) & 1) * P3_BUF, rowbase + 32 * (nch - 1), h, q, lane);
                if (half == 0) p.out[(job == 0 ? O_LHS : O_LHP) + (size_t)b * 1024 + ch] = hc;
            } else {
                const int w = wave - 4, hd = hd0 + (w >> 1), ph = w & 1;
                const f2_t* DTC = (const f2_t*)(p.ws + WS_DTC);
                const float Dh = p.in[23][hd];
                LAS unsigned char* dtl = lds + 2 * P3_BUF + w * 256;
                f32x16 st[4];
                const float* sin = p.in[7] + ((size_t)b * 16 + hd) * 8192;
#pragma unroll
                for (int nb = 0; nb < 4; ++nb)
#pragma unroll
                    for (int r4 = 0; r4 < 4; ++r4) { f32x4 v = {0.f, 0.f, 0.f, 0.f};
                        if (job == 0) v = *(const f32x4*)(sin + (size_t)(ph * 32 + l) * 128 + 32 * nb + 8 * r4 + 4 * half);
                        st[nb][4 * r4 + 0] = v[0]; st[nb][4 * r4 + 1] = v[1]; st[nb][4 * r4 + 2] = v[2]; st[nb][4 * r4 + 3] = v[3]; }
                f2_t dtn = DTC[((unsigned)(rowbase >> 5) * 16u + (unsigned)hd) * 32u + (unsigned)l];
                P3_SYNC();
                p3_stage(p, lds, wave, lane, rowbase, rowbase >> 5, h, g, hd0);
                P3_SYNC();
                for (int c = 0; c < nch; ++c) {
                    const int rb = rowbase + 32 * c;
                    if (c > 0) ssd_flush(p, lds + ((c - 1) & 1) * P3_BUF, rb - 32, w, hd, ph, lane);
                    if (c + 1 < nch) p3_stage(p, lds + ((c + 1) & 1) * P3_BUF, wave, lane, rb + 32, (rb + 32) >> 5, h, g, hd0);
                    const f2_t dtc = dtn;
                    if (c + 1 < nch) dtn = DTC[((unsigned)((rb + 32) >> 5) * 16u + (unsigned)hd) * 32u + (unsigned)l];
                    ssd_chunk(p, lds + (c & 1) * P3_BUF, dtl, st, dtc, rb, w, hd, ph, Dh, lane);
                    P3_SYNC();
                }
                ssd_flush(p, lds + ((nch - 1) & 1) * P3_BUF, rowbase + 32 * (nch - 1), w, hd, ph, lane);
                float* sout = p.out + (job == 0 ? O_SSS : O_SSP) + ((size_t)b * 16 + hd) * 8192;
#pragma unroll
                for (int nb = 0; nb < 4; ++nb)
#pragma unroll
                    for (int r4 = 0; r4 < 4; ++r4) { f32x4 v; v[0] = st[nb][4 * r4]; v[1] = st[nb][4 * r4 + 1]; v[2] = st[nb][4 * r4 + 2]; v[3] = st[nb][4 * r4 + 3];
                        *(f32x4*)(sout + (size_t)(ph * 32 + l) * 128 + 32 * nb + 8 * r4 + 4 * half) = v; }
            }
        }
    }
}

DI void phase5(const Params& p, int r4lo, int r4hi, int blk, int nblk, int wave_s) {
    int tid = tid_of(wave_s); asm volatile("" : "+v"(tid));
    const int lane = tid & 63, wave = __builtin_amdgcn_readfirstlane(tid >> 6);
    const int gw = blk * 8 + wave, NGW = nblk * 8;
    const bf16_t* op = (const bf16_t*)(p.ws + WS_R1);
    const float* psq = (const float*)(p.ws + WS_PSQ);
    f32x4 fg[4];
#pragma unroll
    for (int j = 0; j < 4; ++j) fg[j] = *(const f32x4*)(p.in[26] + 4 * lane + 256 * j);
    for (int r4 = r4lo + gw; r4 < r4hi; r4 += NGW) {
        const size_t row = (size_t)r4 * 4;
        u32x2 a[4][4]; f32x4 q[4][4];
#pragma unroll
        for (int i = 0; i < 4; ++i)
#pragma unroll
            for (int j = 0; j < 4; ++j) { a[i][j] = *(const u32x2*)(op + (row + i) * 1024 + 4 * lane + 256 * j); q[i][j] = *(const f32x4*)(psq + (row + i) * 16 + 4 * j); }
#pragma unroll
        for (int i = 0; i < 4; ++i) { const f32x4 s4 = (q[i][0] + q[i][1]) + (q[i][2] + q[i][3]);
            const float rstd = rsqrtf(((s4[0] + s4[1]) + (s4[2] + s4[3])) * (1.f / 1024.f) + EPS);
            float* o = p.out + (row + i) * 1024 + 4 * lane;
#pragma unroll
            for (int j = 0; j < 4; ++j) { f32x4 v; v[0] = bf_lo(a[i][j].x); v[1] = bf_hi(a[i][j].x); v[2] = bf_lo(a[i][j].y); v[3] = bf_hi(a[i][j].y);
                *(f32x4*)(o + 256 * j) = v * rstd * fg[j]; } }
    }
}

DI void grid_bar(unsigned* ctr, unsigned nb, int wave_s) {
    asm volatile("s_waitcnt vmcnt(0) lgkmcnt(0)" ::: "memory");
    __syncthreads();
    if (tid_of(wave_s) == 0) {
        const unsigned grp = blockIdx.x & 31u, gsz = (gridDim.x - grp + 31u) >> 5, ngrp = gridDim.x < 32u ? gridDim.x : 32u;
        __builtin_amdgcn_fence(__ATOMIC_RELEASE, "agent");
        asm volatile("s_waitcnt vmcnt(0)" ::: "memory");
        const unsigned old = __hip_atomic_fetch_add(ctr + 32u * grp, 1u, __ATOMIC_RELAXED, __HIP_MEMORY_SCOPE_AGENT);
        if (old + 1u == nb * gsz) __hip_atomic_fetch_add(ctr + 32u * 32u, 1u, __ATOMIC_RELAXED, __HIP_MEMORY_SCOPE_AGENT);
        while (__hip_atomic_load(ctr + 32u * 32u, __ATOMIC_RELAXED, __HIP_MEMORY_SCOPE_AGENT) < nb * ngrp) __builtin_amdgcn_s_sleep(4);
        __builtin_amdgcn_fence(__ATOMIC_ACQUIRE, "agent");
        asm volatile("s_waitcnt vmcnt(0)" ::: "memory");
    }
    __syncthreads();
}

constexpr int NPHASE = 7;
template <bool COOP>
__global__ __launch_bounds__(512, 2) void fwd_k(Params p, int ph_lo, int ph_hi) {
    extern __shared__ __attribute__((aligned(16))) unsigned char shm[];
    LAS unsigned char* lds = (LAS unsigned char*)shm;
    const int wave_s = __builtin_amdgcn_readfirstlane((int)threadIdx.x >> 6);
#define RUN(k) (ph_lo <= (k) && (k) < ph_hi && ((PHASE_MASK >> (k)) & 1))
    unsigned* bar_ctr = (unsigned*)(p.ws + WS_CTR);
    if (COOP && ph_hi > 1000) cg::this_grid().sync();
    unsigned nbar = 0;
#define SEAM(k) do { if (COOP && ph_lo <= (k) && (k) + 1 < ph_hi) grid_bar(bar_ctr, ++nbar, wave_s); } while (0)
#define NREP(k) ((((REP_MASK & ~4) >> (k)) & 1) ? 2 : 1)
    for (int rep = 0; rep < NREP(0); ++rep) { if (RUN(0)) phase0(p, lds, wave_s); if (rep + 1 < NREP(0)) cg::this_grid().sync(); }
    SEAM(0);
    for (int rep = 0; rep < NREP(1); ++rep) { if (RUN(1)) phase1(p, lds, wave_s); if (rep + 1 < NREP(1)) cg::this_grid().sync(); }
    SEAM(1);
    for (int rep = 0; rep < NREP(2); ++rep) { if (rep) cg::this_grid().sync(); if (RUN(2)) {
        g8::Gemm g; g.A = (const bf16_t*)(p.ws + WS_R1); g.Bt = (const bf16_t*)(p.ws + WS_WIN); g.lda = 1024; g.ldb = 1024;
        g8::SchedIn S; S.nM = MT / 256; S.nN = LDP / 256; S.G = (int)gridDim.x; S.c = (int)blockIdx.x;
        g8::EpiProj E; E.O = (bf16_t*)(p.ws + WS_PROJ); E.dt = (float*)(p.ws + WS_DT);
        { const int nun = (MT / 256) * (LDP / 256), extra = nun % (int)gridDim.x;
          if (extra > 0 && (int)blockIdx.x >= extra) { const int d = ((int)blockIdx.x - extra) & 7; for (int i = 0; i < d; ++i) __builtin_amdgcn_s_sleep(100); } }
        g8::gemm_phase<g8::EpiProj, g8::SchedIn>(lds, g, S, E, wave_s);
    } }
    SEAM(2);
    for (int rep = 0; rep < NREP(3); ++rep) { if (RUN(3)) phase2b(p, lds, wave_s); if (rep + 1 < NREP(3)) cg::this_grid().sync(); }
    SEAM(3);
    if (RUN(4)) phase3(p, lds, wave_s);
    SEAM(4);
    if (RUN(5)) {
        for (int pass = 0; pass < 2; ++pass) {
            if (pass == 1 && COOP) grid_bar(bar_ctr, ++nbar, wave_s);
            const bool gemm_blk = (pass == 0) || (blockIdx.x < 8 && gridDim.x > 8);
            if (gemm_blk) {
                g8::Gemm g; g.A = (const bf16_t*)(p.ws + WS_PROJ); g.Bt = (const bf16_t*)(p.ws + WS_WOUT); g.lda = LDP; g.ldb = 2048;
                g8::SchedOut S; S.nN = 4; S.c = (int)blockIdx.x;
                S.nM = pass == 0 ? TP / 256 : TS / 256; S.G = pass == 0 ? (int)gridDim.x : 8; S.pm0 = pass == 0 ? 0 : TP / 256;
                g8::EpiOut E; E.ssq = (const float*)(p.ws + WS_SSQ); E.xp = p.in[0]; E.xs = p.in[1]; E.mod = (const float*)(p.ws + WS_MOD);
                E.outp = (bf16_t*)(p.ws + WS_R1); E.psq = (float*)(p.ws + WS_PSQ); E.dummy = 0; E.fl = lds + 131072;
                g8::gemm_phase<g8::EpiOut, g8::SchedOut>(lds, g, S, E, wave_s);
            } else phase5(p, 0, TP / 4, (int)blockIdx.x - 8, (int)gridDim.x - 8, wave_s);
        }
        if (COOP) grid_bar(bar_ctr, ++nbar, wave_s);
        phase5(p, TP / 4, MT / 4, (int)blockIdx.x, (int)gridDim.x, wave_s);
    }
#undef RUN
#undef SEAM
}

extern "C" void kernel_launch(void* const* d_in, const int* in_sizes, int n_in, void* d_out, int out_size, void* d_ws, size_t ws_size, hipStream_t stream) {
    static int grid = 0;
    if (grid == 0) {
        if (n_in != 27 || ws_size < WS_END) { fprintf(stderr, "kernel_launch: unexpected n_in %d or ws_size %zu (< %zu)\n", n_in, ws_size, (size_t)WS_END); grid = -1; return; }
        int dev = 0, cus = 0, per_cu = 0;
        (void)hipGetDevice(&dev);
        (void)hipDeviceGetAttribute(&cus, hipDeviceAttributeMultiprocessorCount, dev);
        (void)hipFuncSetAttribute((const void*)fwd_k<ONE_LAUNCH != 0>, hipFuncAttributeMaxDynamicSharedMemorySize, LDS_BYTES);
        (void)hipOccupancyMaxActiveBlocksPerMultiprocessor(&per_cu, (const void*)fwd_k<ONE_LAUNCH != 0>, 512, LDS_BYTES);
        if (per_cu < 1) fprintf(stderr, "kernel_launch: occupancy query reports %d blocks per CU\n", per_cu);
        (void)hipGetLastError();
        grid = cus > 0 ? cus : 256;
    }
    if (grid < 0) return;
    Params p{};
    for (int i = 0; i < 27; ++i) p.in[i] = (const float*)d_in[i];
    p.out = (float*)d_out; p.ws = (unsigned char*)d_ws;
#if ONE_LAUNCH
    (void)hipMemsetAsync((unsigned char*)d_ws + WS_CTR, 0, 8192, stream);
    int lo = 0, hi = NPHASE;
    void* args[] = {&p, &lo, &hi};
    hipError_t e = hipLaunchCooperativeKernel((const void*)fwd_k<true>, dim3(grid), dim3(512), args, LDS_BYTES, stream);
    if (e != hipSuccess) fprintf(stderr, "cooperative launch failed: %s (grid %d)\n", hipGetErrorString(e), grid);
#else
    for (int ph = 0; ph < NPHASE; ++ph) hipLaunchKernelGGL(fwd_k<false>, dim3(grid), dim3(512), LDS_BYTES, stream, p, ph, ph + 1);
#endif
}
```
